# Optimizing an MI355X kernel written in HIP

```python
import jax
import jax.numpy as jnp
from jax import lax
import numpy as np

D_MODEL = 1024
BATCH = 16
SEQ = 4096
DEPTH = 2
DEC_BATCH = 4
DEC_SEQ = 4096
PAST_LEN = 128

GRID_W = 64
HEAD_DIM = 64
NA_HEADS = 8
NA_WIN_R = 8
NA_WIN_C = 16
DIL_HEADS = 8
DIL_BRANCHES = ((128, 1), (512, 4), (2048, 16))
DIL_QBLOCK = 128
RET_HEADS = 4
RET_QK_DIM = 256
RET_V_DIM = 512
RET_CHUNK = 128
FFN_DIM = 2816
CONV_WIDTH = 3
ROPE_THETA = 10000.0
NORM_EPS = 1e-6
NEG_INF = -1e30
EVEN_MIX = (NA_HEADS + DIL_HEADS) * HEAD_DIM
EVEN_IN = 3 * EVEN_MIX
RET_IN = 2 * RET_HEADS * RET_QK_DIM + 2 * RET_HEADS * RET_V_DIM
RET_MIX = RET_HEADS * RET_V_DIM

kernel_name = 'hybrid_na_dilated_retention_encoder'


def rmsnorm(x, g):
    xf = x.astype(jnp.float32)
    y = xf * lax.rsqrt(jnp.mean(jnp.square(xf), axis=-1, keepdims=True) + NORM_EPS)
    return (y * g.astype(jnp.float32)).astype(x.dtype)


def rotary(x):
    t, dh = x.shape[1], x.shape[-1]
    inv = 1.0 / (ROPE_THETA ** (jnp.arange(0, dh, 2, dtype=jnp.float32) / dh))
    ang = jnp.arange(t, dtype=jnp.float32)[:, None] * inv[None, :]
    cos = jnp.cos(ang)[None, :, None, :]
    sin = jnp.sin(ang)[None, :, None, :]
    xf = x.astype(jnp.float32)
    x1, x2 = xf[..., :dh // 2], xf[..., dh // 2:]
    return jnp.concatenate([x1 * cos - x2 * sin, x1 * sin + x2 * cos], axis=-1).astype(x.dtype)


def neighbourhood_attention(q, k, v, rpb):
    b, t, h, dh = q.shape
    rows = t // GRID_W
    wr = min(NA_WIN_R, rows)
    wc = NA_WIN_C
    qg = q.reshape(b, rows, GRID_W, h, dh)
    kg = k.reshape(b, rows, GRID_W, h, dh)
    vg = v.reshape(b, rows, GRID_W, h, dh)
    col = jnp.arange(GRID_W)
    col_start = jnp.clip(col - wc // 2, 0, GRID_W - wc)
    col_idx = col_start[:, None] + jnp.arange(wc)[None, :]
    col_off = col_idx - col[:, None] + (NA_WIN_C - 1)
    scale = dh ** -0.5
    rpb32 = rpb.astype(jnp.float32)

    def one_row(r):
        row_start = jnp.clip(r - wr // 2, 0, rows - wr)
        qr = lax.dynamic_index_in_dim(qg, r, axis=1, keepdims=False)
        kr = lax.dynamic_slice_in_dim(kg, row_start, wr, axis=1)
        vr = lax.dynamic_slice_in_dim(vg, row_start, wr, axis=1)
        kn = jnp.take(kr, col_idx, axis=2)
        vn = jnp.take(vr, col_idx, axis=2)
        s = jnp.einsum('bqhd,biqjhd->bhqij', qr, kn).astype(jnp.float32) * scale
        row_off = row_start + jnp.arange(wr) - r + (NA_WIN_R - 1)
        bias = rpb32[:, row_off][:, :, col_off].transpose(0, 2, 1, 3)
        s = s + bias[None]
        p = jax.nn.softmax(s.reshape(b, h, GRID_W, wr * wc), axis=-1).reshape(b, h, GRID_W, wr, wc)
        return jnp.einsum('bhqij,biqjhd->bqhd', p.astype(v.dtype), vn)

    out = lax.map(one_row, jnp.arange(rows))
    return out.transpose(1, 0, 2, 3, 4).reshape(b, t, h, dh)


def dilated_branch(q, k, v, dilation, half):
    b, t, h, dh = q.shape
    L = t // dilation
    nblk = -(-L // DIL_QBLOCK)
    Lp = nblk * DIL_QBLOCK
    kw = DIL_QBLOCK + 2 * half

    def to_res(a):
        return a.reshape(b, L, dilation, h, dh).transpose(0, 2, 1, 3, 4).reshape(b * dilation, L, h, dh)

    qr = jnp.pad(to_res(q), ((0, 0), (0, Lp - L), (0, 0), (0, 0)))
    kr = jnp.pad(to_res(k), ((0, 0), (half, Lp - L + half), (0, 0), (0, 0)))
    vr = jnp.pad(to_res(v), ((0, 0), (half, Lp - L + half), (0, 0), (0, 0)))
    qi = jnp.arange(DIL_QBLOCK)
    kj = jnp.arange(kw)
    rel = kj[None, :] - half - qi[:, None]
    scale = dh ** -0.5

    def one_block(blk):
        s0 = blk * DIL_QBLOCK
        qb = lax.dynamic_slice_in_dim(qr, s0, DIL_QBLOCK, axis=1)
        kb = lax.dynamic_slice_in_dim(kr, s0, kw, axis=1)
        vb = lax.dynamic_slice_in_dim(vr, s0, kw, axis=1)
        kpos = s0 - half + kj
        valid = (jnp.abs(rel) <= half) & ((kpos >= 0) & (kpos < L))[None, :]
        s = jnp.einsum('nqhd,nkhd->nhqk', qb, kb).astype(jnp.float32) * scale
        s = jnp.where(valid[None, None], s, NEG_INF)
        m = jnp.max(s, axis=-1, keepdims=True)
        e = jnp.exp(s - m)
        z = jnp.sum(e, axis=-1)
        o = jnp.einsum('nhqk,nkhd->nqhd', (e / z[..., None]).astype(v.dtype), vb)
        lse = (m[..., 0] + jnp.log(z)).transpose(0, 2, 1)
        return o, lse

    o, lse = lax.map(one_block, jnp.arange(nblk))
    o = o.transpose(1, 0, 2, 3, 4).reshape(b * dilation, Lp, h, dh)[:, :L]
    lse = lse.transpose(1, 0, 2, 3).reshape(b * dilation, Lp, h)[:, :L]
    o = o.reshape(b, dilation, L, h, dh).transpose(0, 2, 1, 3, 4).reshape(b, t, h, dh)
    lse = lse.reshape(b, dilation, L, h).transpose(0, 2, 1, 3).reshape(b, t, h)
    return o, lse


def dilated_attention(q, k, v):
    outs, lses = [], []
    for window, dilation in DIL_BRANCHES:
        o, lse = dilated_branch(q, k, v, dilation, (window // 2) // dilation)
        outs.append(o)
        lses.append(lse)
    wts = jax.nn.softmax(jnp.stack(lses, axis=0), axis=0)
    return jnp.einsum('nbth,nbthd->bthd', wts.astype(q.dtype), jnp.stack(outs, axis=0))


def even_mixer(h, w_in, rpb, w_out):
    b, t, _ = h.shape
    proj = h @ w_in
    n_na = 3 * NA_HEADS * HEAD_DIM
    na = proj[..., :n_na].reshape(b, t, 3, NA_HEADS, HEAD_DIM)
    dl = proj[..., n_na:].reshape(b, t, 3, DIL_HEADS, HEAD_DIM)
    oa = neighbourhood_attention(na[:, :, 0], na[:, :, 1], na[:, :, 2], rpb)
    ob = dilated_attention(rotary(dl[:, :, 0]), rotary(dl[:, :, 1]), dl[:, :, 2])
    o = jnp.concatenate([oa.reshape(b, t, NA_HEADS * HEAD_DIM), ob.reshape(b, t, DIL_HEADS * HEAD_DIM)], axis=-1)
    return o @ w_out


def chunk_retention(q, k, v, log_gamma, include_diag):
    b, t, h, dk = q.shape
    dv = v.shape[-1]
    c = RET_CHUNK
    n = t // c

    def chunks(a):
        return a.reshape(b, n, c, h, a.shape[-1]).transpose(1, 0, 3, 2, 4)

    pos = jnp.arange(c, dtype=jnp.float32)
    diff = pos[:, None] - pos[None, :]
    mask = (diff >= 0) if include_diag else (diff > 0)
    lg = log_gamma.astype(jnp.float32)
    decay_in = jnp.where(mask, jnp.exp(lg[:, None, None] * jnp.where(mask, diff, 0.0)), 0.0)[None].astype(q.dtype)
    q_decay = jnp.exp(lg[:, None] * (pos + 1.0))[None, :, :, None].astype(q.dtype)
    k_decay = jnp.exp(lg[:, None] * (c - 1.0 - pos))[None, :, :, None].astype(q.dtype)
    s_decay = jnp.exp(lg * c)[None, :, None, None].astype(q.dtype)

    def step(state, inp):
        qc, kc, vc = inp
        inner = jnp.einsum('bhqd,bhkd->bhqk', qc, kc) * decay_in
        out = jnp.einsum('bhqk,bhkv->bhqv', inner, vc) + jnp.einsum('bhqd,bhdv->bhqv', qc * q_decay, state)
        state = state * s_decay + jnp.einsum('bhkd,bhkv->bhdv', kc * k_decay, vc)
        return state, out

    state0 = jnp.zeros((b, h, dk, dv), q.dtype)
    _, out = lax.scan(step, state0, (chunks(q), chunks(k), chunks(v)))
    return out.transpose(1, 0, 3, 2, 4).reshape(b, t, h, dv)


def retention_mixer(h, w_in, decay_fwd_raw, decay_bwd_raw, w_out):
    b, t, _ = h.shape
    nq = RET_HEADS * RET_QK_DIM
    nv = RET_HEADS * RET_V_DIM
    proj = h @ w_in
    q = proj[..., :nq].reshape(b, t, RET_HEADS, RET_QK_DIM)
    k = proj[..., nq:2 * nq].reshape(b, t, RET_HEADS, RET_QK_DIM)
    v = proj[..., 2 * nq:2 * nq + nv].reshape(b, t, RET_HEADS, RET_V_DIM)
    g = proj[..., 2 * nq + nv:]
    q = rotary(q) * (RET_QK_DIM ** -0.5)
    k = rotary(k)
    log_g_f = -jax.nn.softplus(decay_fwd_raw.astype(jnp.float32))
    log_g_b = -jax.nn.softplus(decay_bwd_raw.astype(jnp.float32))
    fwd = chunk_retention(q, k, v, log_g_f, True)
    bwd = jnp.flip(chunk_retention(jnp.flip(q, 1), jnp.flip(k, 1), jnp.flip(v, 1), log_g_b, False), 1)
    r = (fwd + bwd).astype(jnp.float32)
    mu = jnp.mean(r, axis=-1, keepdims=True)
    var = jnp.mean(jnp.square(r - mu), axis=-1, keepdims=True)
    r = ((r - mu) * lax.rsqrt(var + NORM_EPS)).astype(h.dtype).reshape(b, t, nv)
    return (jax.nn.silu(g) * r) @ w_out


def conv_ffn(h, w_up, conv_w, conv_b, w_down):
    t = h.shape[1]
    a = h @ w_up
    pad = CONV_WIDTH // 2
    ap = jnp.pad(a, ((0, 0), (pad, pad), (0, 0)))
    y = conv_b
    for j in range(CONV_WIDTH):
        y = y + ap[:, j:j + t] * conv_w[j]
    u, gate = y[..., :FFN_DIM], y[..., FFN_DIM:]
    return (u * jax.nn.gelu(gate)) @ w_down


def encoder_trunk(x, attn_norm, even_w_in, na_rpb, even_w_out, ret_w_in, ret_decay_fwd, ret_decay_bwd,
                  ret_w_out, ffn_norm, ffn_w_up, ffn_conv_w, ffn_conv_b, ffn_w_down, final_norm):
    for layer in range(DEPTH):
        h = rmsnorm(x, attn_norm[layer])
        if layer % 2 == 0:
            e = layer // 2
            x = x + even_mixer(h, even_w_in[e], na_rpb[e], even_w_out[e])
        else:
            o = layer // 2
            x = x + retention_mixer(h, ret_w_in[o], ret_decay_fwd[o], ret_decay_bwd[o], ret_w_out[o])
        h = rmsnorm(x, ffn_norm[layer])
        x = x + conv_ffn(h, ffn_w_up[layer], ffn_conv_w[layer], ffn_conv_b[layer], ffn_w_down[layer])
    return rmsnorm(x, final_norm)


def setup_inputs(seed: int = 0) -> dict:
    key = jax.random.key(seed)
    ks = jax.random.split(key, 16)
    f32 = jnp.float32
    n_even = (DEPTH + 1) // 2
    n_odd = DEPTH // 2

    def normal(k, shape, scale):
        return jax.random.normal(k, shape, f32) * scale

    neg_log_gamma = -jnp.log1p(-(2.0 ** (-5.0 - jnp.arange(RET_HEADS, dtype=f32))))
    decay_base = jnp.log(jnp.expm1(neg_log_gamma))
    return {
        'x_prompt': normal(ks[0], (BATCH, SEQ, D_MODEL), 1.0),
        'x_sample': normal(ks[1], (DEC_BATCH, DEC_SEQ, D_MODEL), 1.0),
        'attn_norm': 1.0 + normal(ks[2], (DEPTH, D_MODEL), 0.01),
        'even_w_in': normal(ks[3], (n_even, D_MODEL, EVEN_IN), D_MODEL ** -0.5),
        'na_rpb': normal(ks[4], (n_even, NA_HEADS, 2 * NA_WIN_R - 1, 2 * NA_WIN_C - 1), 0.1),
        'even_w_out': normal(ks[5], (n_even, EVEN_MIX, D_MODEL), EVEN_MIX ** -0.5),
        'ret_w_in': normal(ks[6], (n_odd, D_MODEL, RET_IN), D_MODEL ** -0.5),
        'ret_decay_fwd': decay_base[None, :] + normal(ks[7], (n_odd, RET_HEADS), 0.1),
        'ret_decay_bwd': decay_base[None, :] + normal(ks[8], (n_odd, RET_HEADS), 0.1),
        'ret_w_out': normal(ks[9], (n_odd, RET_MIX, D_MODEL), RET_MIX ** -0.5),
        'ffn_norm': 1.0 + normal(ks[10], (DEPTH, D_MODEL), 0.01),
        'ffn_w_up': normal(ks[11], (DEPTH, D_MODEL, 2 * FFN_DIM), D_MODEL ** -0.5),
        'ffn_conv_w': normal(ks[12], (DEPTH, CONV_WIDTH, 2 * FFN_DIM), CONV_WIDTH ** -0.5),
        'ffn_conv_b': normal(ks[13], (DEPTH, 2 * FFN_DIM), 0.01),
        'ffn_w_down': normal(ks[14], (DEPTH, FFN_DIM, D_MODEL), FFN_DIM ** -0.5),
        'final_norm': 1.0 + normal(ks[15], (D_MODEL,), 0.01),
    }


def reference(x_prompt, x_sample, attn_norm, even_w_in, na_rpb, even_w_out, ret_w_in, ret_decay_fwd,
              ret_decay_bwd, ret_w_out, ffn_norm, ffn_w_up, ffn_conv_w, ffn_conv_b, ffn_w_down, final_norm):
    y_prompt = encoder_trunk(x_prompt, attn_norm, even_w_in, na_rpb, even_w_out, ret_w_in, ret_decay_fwd,
                             ret_decay_bwd, ret_w_out, ffn_norm, ffn_w_up, ffn_conv_w, ffn_conv_b, ffn_w_down,
                             final_norm)
    y_sample = encoder_trunk(x_sample, attn_norm, even_w_in, na_rpb, even_w_out, ret_w_in, ret_decay_fwd,
                             ret_decay_bwd, ret_w_out, ffn_norm, ffn_w_up, ffn_conv_w, ffn_conv_b, ffn_w_down,
                             final_norm)
    return (y_prompt, y_sample)
```

```cpp
#include <hip/hip_runtime.h>
#include <hip/hip_cooperative_groups.h>
#include <cstdio>
namespace cg = cooperative_groups;

#define DI __device__ __forceinline__
#define LAS __attribute__((address_space(3)))
typedef short s16x4 __attribute__((ext_vector_type(4)));
typedef float f32x16 __attribute__((ext_vector_type(16)));
typedef __bf16 bf16v2 __attribute__((ext_vector_type(2)));
typedef float f32v2 __attribute__((ext_vector_type(2)));

namespace pg8 {
#define PG8_LAS __attribute__((address_space(3)))
typedef unsigned short bf16_t;
typedef short bf16x8 __attribute__((ext_vector_type(8)));
typedef float f32x4 __attribute__((ext_vector_type(4)));
typedef unsigned u32x4 __attribute__((ext_vector_type(4)));
constexpr int BM = 256, BK = 64, HALF = 128, HTB = HALF * BK * 2  , STAGE_BYTES = 8 * HTB, NXCD = 8, WGM = 8;

__host__ __device__ __forceinline__ int lds_byte(int r, int c) { const int st = (r >> 4) * 2 + (c >> 5), rr = r & 15, cc = c & 31, ob = rr * 64 + cc * 2; return st * 1024 + (ob ^ (((ob >> 9) & 1) << 5)); }
__host__ __device__ __forceinline__ void stage_rc(int b, int& R, int& C) { const int st = b / 1024, sb = b % 1024, swz = sb ^ (((sb >> 9) & 1) << 5); R = (st >> 1) * 16 + swz / 64; C = (st & 1) * 32 + (swz % 64) / 2; }
__host__ __device__ __forceinline__ int perm32(int rho) { const int n = rho >> 4, i = rho & 15; return 8 * (i >> 2) + 4 * n + (i & 3); }

struct Unit { int pm, pn; };
struct Gemm { const bf16_t* A; const bf16_t* Bt; int M, N, K; };
struct StaticOrder {
    int nM, nN, nwg, G, c;
    __host__ __device__ void init(int M, int N, int G_, int c_) { nM = M / BM; nN = N / BM; nwg = nM * nN; G = G_; c = c_; }
    __host__ __device__ bool next(int i, Unit& u) const {
        const long L = (long)i * G + c; if (L >= nwg) return false;
        int wgid = (int)L; { const int q = nwg / NXCD, r = nwg % NXCD, xcd = wgid % NXCD, off = wgid / NXCD; wgid = (xcd < r ? xcd * (q + 1) : r * (q + 1) + (xcd - r) * q) + off; }
        const int nig = WGM * nN, gid = wgid / nig, fm = gid * WGM, gsz = (nM - fm) < WGM ? (nM - fm) : WGM;
        u.pm = fm + ((wgid % nig) % gsz); u.pn = (wgid % nig) / gsz; return true;
    }
    __device__ __forceinline__ void a_ready(const Unit&) const {}
    __device__ __forceinline__ void done(const Unit&) const {}
};
__device__ __forceinline__ unsigned cvt_pk_bf16(float lo, float hi) { unsigned r; asm volatile("v_cvt_pk_bf16_f32 %0, %1, %2" : "=v"(r) : "v"(lo), "v"(hi)); return r; }
template <class Epi, class Sched>
__device__ __forceinline__ void gemm_phase(PG8_LAS unsigned char* lds, const Gemm g, const Sched& S, const Epi& E) {
    int tid_o = __builtin_amdgcn_readfirstlane((int)threadIdx.x >> 6) * 64 + (int)__builtin_amdgcn_mbcnt_hi(~0u, __builtin_amdgcn_mbcnt_lo(~0u, 0u)); asm volatile("" : "+v"(tid_o));
    const int tid = tid_o, wid = __builtin_amdgcn_readfirstlane(tid >> 6), lane = tid & 63, wr = wid >> 2, wc = wid & 3, fr = lane & 15, fq = lane >> 4;
    const int K = g.K, nt = K / BK;
    unsigned voffA[2], voffB[2];
#pragma unroll
    for (int i = 0; i < 2; ++i) { int R, C; stage_rc(tid * 16 + i * 8192, R, C); const int Rb = Epi::PERM ? ((R & ~31) + perm32(R & 31)) : R;
        voffA[i] = (unsigned)(R * K + C) * 2u; voffB[i] = (unsigned)(Rb * K + C) * 2u; }
    const size_t kstep = (size_t)(BK * 2);
    const size_t hstep = (size_t)HALF * K * 2;
    const size_t tstep = 2 * hstep;
    const unsigned ldsw = (unsigned)wid * 1024u;
    const int aoff = lds_byte(wr * 64 + fr, fq * 8), boff = lds_byte(wc * 32 + fr, fq * 8);
#define PG8_SA(b, h) (((b) * 2 + (h)) * HTB)
#define PG8_SB(b, h) ((4 + (b) * 2 + (h)) * HTB)
#define PG8_STAGE(bufoff, gbase, voff) do { _Pragma("unroll") for (int _i = 0; _i < 2; ++_i) \
        __builtin_amdgcn_global_load_lds((const unsigned*)((const char*)(gbase) + (voff)[_i]), (PG8_LAS unsigned*)(lds + (bufoff) + ldsw + _i * 8192), 16, 0, 0); } while (0)
#define PG8_LDA(dst, b, h) do { _Pragma("unroll") for (int m = 0; m < 4; ++m) _Pragma("unroll") for (int k = 0; k < 2; ++k) dst[m][k] = *(const PG8_LAS bf16x8*)(lds + PG8_SA(b, h) + aoff + m * 2048 + k * 1024); } while (0)
#define PG8_LDB(dst, b, h) do { _Pragma("unroll") for (int n = 0; n < 2; ++n) _Pragma("unroll") for (int k = 0; k < 2; ++k) dst[n][k] = *(const PG8_LAS bf16x8*)(lds + PG8_SB(b, h) + boff + n * 2048 + k * 1024); } while (0)
#define PG8_MMA(ai, bj, At, Bt) do { __builtin_amdgcn_s_setprio(1); _Pragma("unroll") for (int m = 0; m < 4; ++m) _Pragma("unroll") for (int n = 0; n < 2; ++n) _Pragma("unroll") for (int k = 0; k < 2; ++k) \
        acc[ai][bj][m][n] = __builtin_amdgcn_mfma_f32_16x16x32_bf16(Bt[n][k], At[m][k], acc[ai][bj][m][n], 0, 0, 0); __builtin_amdgcn_s_setprio(0); } while (0)
#define PG8_WAIT_V(n) asm volatile("s_waitcnt vmcnt(" #n ")" ::: "memory")
#define PG8_WAIT_L(n) asm volatile("s_waitcnt lgkmcnt(" #n ")" ::: "memory")
#define PG8_BAR __builtin_amdgcn_s_barrier()
#define PG8_SCHED __builtin_amdgcn_sched_barrier(0)
    Unit cur, nxt; int ui = 0;
    if (!S.next(0, cur)) return;
    f32x4 acc[2][2][4][2];
#pragma unroll
    for (int a = 0; a < 2; ++a)
#pragma unroll
        for (int b = 0; b < 2; ++b)
#pragma unroll
            for (int m = 0; m < 4; ++m)
#pragma unroll
                for (int n = 0; n < 2; ++n) acc[a][b][m][n] = (f32x4){0.f, 0.f, 0.f, 0.f};
    bf16x8 At[4][2], B0[2][2], B1[2][2];
    const char* cA = (const char*)g.A + (size_t)cur.pm * tstep; const char* cB = (const char*)g.Bt + (size_t)cur.pn * tstep;
    S.a_ready(cur);
    PG8_STAGE(PG8_SB(0, 0), cB, voffB); PG8_STAGE(PG8_SB(0, 1), cB + hstep, voffB); PG8_STAGE(PG8_SA(0, 0), cA, voffA); PG8_STAGE(PG8_SA(0, 1), cA + hstep, voffA);
    if (wr == 1) PG8_BAR;
    PG8_WAIT_V(2); PG8_BAR;
    PG8_STAGE(PG8_SB(1, 0), cB + kstep, voffB); PG8_STAGE(PG8_SA(1, 0), cA + kstep, voffA); PG8_STAGE(PG8_SB(1, 1), cB + hstep + kstep, voffB);
    PG8_WAIT_V(6); PG8_BAR;
    for (;;) {
        const bool has_next = S.next(ui + 1, nxt);
        const char* nA = has_next ? (const char*)g.A + (size_t)nxt.pm * tstep : cA; const char* nB = has_next ? (const char*)g.Bt + (size_t)nxt.pn * tstep : cB;
        for (int t = 0; t < nt; t += 2) {
            const bool last = (t == nt - 2);
            const char* a1 = cA + (size_t)(t + 1) * kstep;
            const char* a2 = last ? nA : cA + (size_t)(t + 2) * kstep; const char* b2 = last ? nB : cB + (size_t)(t + 2) * kstep;
            const char* a3 = a2 + kstep; const char* b3 = b2 + kstep;
            if (last && has_next) S.a_ready(nxt);
            PG8_LDB(B0, 0, 0); PG8_LDB(B1, 0, 1); PG8_SCHED; PG8_LDA(At, 0, 0); PG8_STAGE(PG8_SA(1, 1), a1 + hstep, voffA);
            PG8_WAIT_V(8); PG8_WAIT_L(0); PG8_BAR; PG8_MMA(0, 0, At, B0); PG8_MMA(0, 1, At, B1); PG8_BAR; PG8_SCHED;
            PG8_LDA(At, 0, 1); PG8_STAGE(PG8_SB(0, 0), b2, voffB); PG8_STAGE(PG8_SB(0, 1), b2 + hstep, voffB); PG8_STAGE(PG8_SA(0, 0), a2, voffA);
            PG8_WAIT_V(8); PG8_WAIT_L(0); PG8_BAR; PG8_MMA(1, 0, At, B0); PG8_MMA(1, 1, At, B1); PG8_BAR; PG8_SCHED;
            PG8_LDB(B0, 1, 0); PG8_LDB(B1, 1, 1); PG8_SCHED; PG8_LDA(At, 1, 0); PG8_STAGE(PG8_SA(0, 1), a2 + hstep, voffA);
            PG8_WAIT_V(8); PG8_WAIT_L(0); PG8_BAR; PG8_MMA(0, 0, At, B0); PG8_MMA(0, 1, At, B1); PG8_BAR; PG8_SCHED;
            PG8_LDA(At, 1, 1); PG8_STAGE(PG8_SB(1, 0), b3, voffB); PG8_STAGE(PG8_SB(1, 1), b3 + hstep, voffB); PG8_STAGE(PG8_SA(1, 0), a3, voffA);
            PG8_WAIT_V(8); PG8_WAIT_L(0); PG8_BAR; PG8_MMA(1, 0, At, B0); PG8_MMA(1, 1, At, B1); PG8_BAR; PG8_SCHED;
        }
        if (wr == 0) PG8_BAR;
        if constexpr (!Epi::AFTER_DRAIN) { E(acc, cur, wr, wc, fr, fq, ui); S.done(cur); }
        if (!has_next) break;
#pragma unroll
        for (int a = 0; a < 2; ++a)
#pragma unroll
            for (int b = 0; b < 2; ++b)
#pragma unroll
                for (int m = 0; m < 4; ++m)
#pragma unroll
                    for (int n = 0; n < 2; ++n) acc[a][b][m][n] = (f32x4){0.f, 0.f, 0.f, 0.f};
        cur = nxt; cA = nA; cB = nB; ++ui;
        if (wr == 1) PG8_BAR;
    }
    PG8_WAIT_V(0);
    PG8_BAR;
    if constexpr (Epi::AFTER_DRAIN) { E.fused(acc, cur, wr, wc, fr, fq, lds, wid, lane); S.done(cur); }
#undef PG8_SA
#undef PG8_SB
#undef PG8_STAGE
#undef PG8_LDA
#undef PG8_LDB
#undef PG8_MMA
#undef PG8_WAIT_V
#undef PG8_WAIT_L
#undef PG8_BAR
#undef PG8_SCHED
}
}

using pg8::bf16_t; using pg8::bf16x8; using pg8::f32x4; using pg8::u32x4;
typedef unsigned u32x2 __attribute__((ext_vector_type(2)));

constexpr int D = 1024, SEQ = 4096, GSEQ = 8, TG = GSEQ * SEQ  , NGRP = 3  ;
constexpr int EIN = 3072, RIN = 6144, F2 = 5632, FF = 2816, RMIX = 2048;
constexpr float LOG2E = 1.4426950408889634f;
constexpr int NTHR = 512;
constexpr int LDS_BYTES = 160 * 1024;

constexpr size_t WS_WIN0 = 0;
constexpr size_t WS_WOUT0 = WS_WIN0 + (size_t)EIN * D * 2;
constexpr size_t WS_WRIN = WS_WOUT0 + (size_t)D * D * 2;
constexpr size_t WS_WROUT = WS_WRIN + (size_t)RIN * D * 2;
constexpr size_t WS_WUP = WS_WROUT + (size_t)D * RMIX * 2;
constexpr size_t WS_WDN = WS_WUP + 2 * (size_t)F2 * D * 2;
constexpr size_t WS_ROPE64 = WS_WDN + 2 * (size_t)D * FF * 2;
constexpr size_t WS_ROPE256 = WS_ROPE64 + (size_t)SEQ * 32 * 8;
constexpr size_t WS_H = WS_ROPE256 + (size_t)SEQ * 128 * 8;
constexpr size_t WS_R = WS_H + (size_t)TG * D * 2;
constexpr size_t WS_P = WS_R + 2 * (size_t)TG * RMIX * 2;
constexpr size_t WS_O = WS_P + (size_t)TG * RIN * 2;
constexpr size_t WS_BAR = WS_O + (size_t)TG * FF * 2;
constexpr size_t WS_SS = WS_BAR + 16384;
constexpr size_t WS_LG2 = WS_SS + 4 * (size_t)TG * 64;
constexpr size_t WS_EDGE = WS_LG2 + 256;
constexpr size_t WS_END = WS_EDGE + (size_t)(TG / 64) * 4 * F2 * 2;

struct Params {
    const float* xp; const float* xs; const float* attn_norm; const float* even_w_in; const float* na_rpb; const float* even_w_out;
    const float* ret_w_in; const float* dec_f; const float* dec_b; const float* ret_w_out; const float* ffn_norm; const float* ffn_w_up;
    const float* conv_w; const float* conv_b; const float* ffn_w_down; const float* final_norm;
    float* out; unsigned char* ws;
};

DI unsigned pack_bf16(float lo, float hi) { f32v2 f = {lo, hi}; bf16v2 b = __builtin_convertvector(f, bf16v2); return __builtin_bit_cast(unsigned, b); }
DI float bf_lo(unsigned u) { return __uint_as_float(u << 16); }
DI float bf_hi(unsigned u) { return __uint_as_float(u & 0xffff0000u); }
DI int raw_tid() { return __builtin_amdgcn_readfirstlane((int)threadIdx.x >> 6) * 64 + (int)__builtin_amdgcn_mbcnt_hi(~0u, __builtin_amdgcn_mbcnt_lo(~0u, 0u)); }
DI int otid() { int t = raw_tid(); asm volatile("" : "+v"(t)); return t; }
DI int vblock() { const int G = gridDim.x, bx = blockIdx.x; return (G & 7) == 0 ? (bx & 7) * (G >> 3) + (bx >> 3) : bx; }
DI float fexp2(float x) { return __builtin_amdgcn_exp2f(x); }
DI float shx(float v, int o) { int l = (int)__builtin_amdgcn_mbcnt_hi(~0u, __builtin_amdgcn_mbcnt_lo(~0u, 0u)); asm volatile("" : "+v"(l)); return __int_as_float(__builtin_amdgcn_ds_bpermute((l ^ o) << 2, __float_as_int(v))); }
DI float wave_sum(float v) {
#pragma unroll
    for (int o = 32; o >= 1; o >>= 1) v += shx(v, o);
    return v;
}
DI bf16x8 lds_r128(LAS unsigned char* L, int off) { return *(LAS bf16x8*)(L + off); }
DI void lds_w128(LAS unsigned char* L, int off, bf16x8 v) { *(LAS bf16x8*)(L + off) = v; }
DI s16x4 lds_tr(LAS unsigned char* L, int off) { return __builtin_amdgcn_ds_read_tr16_b64_v4i16((LAS s16x4*)(L + off)); }
DI bf16x8 cat4(s16x4 lo, s16x4 hi) { return __builtin_shufflevector(lo, hi, 0, 1, 2, 3, 4, 5, 6, 7); }
DI f32x16 mfma32(bf16x8 a, bf16x8 b, f32x16 c) { return __builtin_amdgcn_mfma_f32_32x32x16_bf16(a, b, c, 0, 0, 0); }
DI f32x4 mfma16(bf16x8 a, bf16x8 b, f32x4 c) { return __builtin_amdgcn_mfma_f32_16x16x32_bf16(a, b, c, 0, 0, 0); }
DI void unpack8(const u32x4 a, float* f) {
#pragma unroll
    for (int j = 0; j < 4; ++j) { f[2 * j] = bf_lo(a[j]); f[2 * j + 1] = bf_hi(a[j]); }
}
DI bf16x8 pack8(const float* v) { u32x4 w; w.x = pack_bf16(v[0], v[1]); w.y = pack_bf16(v[2], v[3]); w.z = pack_bf16(v[4], v[5]); w.w = pack_bf16(v[6], v[7]); return __builtin_bit_cast(bf16x8, w); }

constexpr int RS_LDS_OFF = 131072, RS_MAX_UNITS = 30;
static_assert(RS_LDS_OFF + RS_MAX_UNITS * 1024 <= LDS_BYTES - 16, "row-scale table");
struct EpiBf16 {
    static constexpr bool PERM = true, AFTER_DRAIN = false, NEEDS_RS = true;
    bf16_t* O; int ldc; const float* ss; LAS unsigned char* L; const float2* rtab; int rpn0, rpn1, rhd;
    DI void operator()(const f32x4 (&acc)[2][2][4][2], const pg8::Unit& u, int wr, int wc, int fr, int fq, int ui) const {
        const int row0 = u.pm * 256 + wr * 64 + fr, col0 = u.pn * 256 + wc * 32 + 8 * fq;
        const LAS float* tab = (const LAS float*)(L + RS_LDS_OFF) + ui * 256 + wr * 64 + fr;
        float rs[2][4];
#pragma unroll
        for (int ai = 0; ai < 2; ++ai)
#pragma unroll
            for (int m = 0; m < 4; ++m) rs[ai][m] = tab[ai * 128 + m * 16];
        const bool rot = (u.pn >= rpn0) && (u.pn < rpn1);
        if (!rot) {
#pragma unroll
            for (int ai = 0; ai < 2; ++ai)
#pragma unroll
                for (int m = 0; m < 4; ++m) { bf16_t* rowp = O + (size_t)(row0 + ai * 128 + m * 16) * ldc + col0;
                    const float sc = rs[ai][m];
#pragma unroll
                    for (int bj = 0; bj < 2; ++bj) { const f32x4 v0 = acc[ai][bj][m][0] * sc, v1 = acc[ai][bj][m][1] * sc;
                        u32x4 w; w.x = pack_bf16(v0[0], v0[1]); w.y = pack_bf16(v0[2], v0[3]); w.z = pack_bf16(v1[0], v1[1]); w.w = pack_bf16(v1[2], v1[3]);
                        *(u32x4*)(rowp + bj * 128) = w; } }
        } else {
            const int hpairs = rhd >> 1;
#pragma unroll
            for (int ai = 0; ai < 2; ++ai)
#pragma unroll
                for (int bj = 0; bj < 2; ++bj) {
                    const int i0 = ((col0 + bj * 128) & (rhd - 1)) >> 1;
                    f32x4 cs[4][2];
#pragma unroll
                    for (int m = 0; m < 4; ++m) { const int pos = (row0 + ai * 128 + m * 16) & (SEQ - 1); const f32x4* tp = (const f32x4*)(rtab + (size_t)pos * hpairs + i0); cs[m][0] = tp[0]; cs[m][1] = tp[1]; }
#pragma unroll
                    for (int m = 0; m < 4; ++m) {
                        const float sc = rs[ai][m];
                        const f32x4 v0 = acc[ai][bj][m][0] * sc, v1 = acc[ai][bj][m][1] * sc;
                        const f32x4 c0 = cs[m][0], c1 = cs[m][1];
                        u32x4 w;
                        w.x = pack_bf16(v0[0] * c0[0] - v0[1] * c0[1], v0[0] * c0[1] + v0[1] * c0[0]);
                        w.y = pack_bf16(v0[2] * c0[2] - v0[3] * c0[3], v0[2] * c0[3] + v0[3] * c0[2]);
                        w.z = pack_bf16(v1[0] * c1[0] - v1[1] * c1[1], v1[0] * c1[1] + v1[1] * c1[0]);
                        w.w = pack_bf16(v1[2] * c1[2] - v1[3] * c1[3], v1[2] * c1[3] + v1[3] * c1[2]);
                        *(u32x4*)(O + (size_t)(row0 + ai * 128 + m * 16) * ldc + col0 + bj * 128) = w;
                    }
                }
        }
    }
};
template <bool LAST> struct EpiRes {
    static constexpr bool PERM = true, AFTER_DRAIN = false, NEEDS_RS = false;
    bf16_t* hb; float* out; float* ss;
    DI void operator()(const f32x4 (&acc)[2][2][4][2], const pg8::Unit& u, int wr, int wc, int fr, int fq, int) const {
        const int row0 = u.pm * 256 + wr * 64 + fr, col0 = u.pn * 256 + wc * 32 + 8 * fq;
#pragma unroll
        for (int ai = 0; ai < 2; ++ai) {
            u32x4 r[4][2];
#pragma unroll
            for (int m = 0; m < 4; ++m) { const size_t ro = (size_t)(row0 + ai * 128 + m * 16) * D + col0;
#pragma unroll
                for (int bj = 0; bj < 2; ++bj) r[m][bj] = *(const u32x4*)(hb + ro + bj * 128); }
            asm volatile("" ::: "memory");
#pragma unroll
            for (int m = 0; m < 4; ++m) { const size_t ro = (size_t)(row0 + ai * 128 + m * 16) * D + col0;
                float sq = 0.f;
#pragma unroll
                for (int bj = 0; bj < 2; ++bj) {
                    const u32x4 rr = r[m][bj];
                    const f32x4 v0 = (f32x4){bf_lo(rr[0]), bf_hi(rr[0]), bf_lo(rr[1]), bf_hi(rr[1])} + acc[ai][bj][m][0];
                    const f32x4 v1 = (f32x4){bf_lo(rr[2]), bf_hi(rr[2]), bf_lo(rr[3]), bf_hi(rr[3])} + acc[ai][bj][m][1];
                    if (LAST) { *(f32x4*)(out + ro + bj * 128) = v0; *(f32x4*)(out + ro + bj * 128 + 4) = v1; }
                    else {
                        u32x4 w; w.x = pack_bf16(v0[0], v0[1]); w.y = pack_bf16(v0[2], v0[3]); w.z = pack_bf16(v1[0], v1[1]); w.w = pack_bf16(v1[2], v1[3]);
                        *(u32x4*)(hb + ro + bj * 128) = w;
                        sq += v0[0] * v0[0] + v0[1] * v0[1] + v0[2] * v0[2] + v0[3] * v0[3] + v1[0] * v1[0] + v1[1] * v1[1] + v1[2] * v1[2] + v1[3] * v1[3];
                    }
                }
                if (!LAST) {
                    sq += shx(sq, 16); sq += shx(sq, 32);
                    if (fq == 0) ss[(size_t)(row0 + ai * 128 + m * 16) * 16 + u.pn * 4 + wc] = sq;
                }
            }
        }
    }
};
DI float gelu_tanh(float x) { const float t = x * (1.5957691216057308f + 0.0713548162726009f * x * x); return x * __builtin_amdgcn_rcpf(1.0f + fexp2(-LOG2E * t)); }
DI float rotr1(float v) { return __int_as_float(__builtin_amdgcn_mov_dpp(__float_as_int(v), 0x121, 0xf, 0xf, false)); }
DI float rotl1(float v) { return __int_as_float(__builtin_amdgcn_mov_dpp(__float_as_int(v), 0x12f, 0xf, 0xf, false)); }
struct EpiConv {
    static constexpr bool PERM = true, AFTER_DRAIN = false, NEEDS_RS = true;
    bf16_t* O; const float* ss; LAS unsigned char* L; const float* cw; const float* cb; bf16_t* edge;
    DI void operator()(const f32x4 (&acc)[2][2][4][2], const pg8::Unit& u, int wr, int wc, int fr, int fq, int ui) const {
        const LAS float* tab = (const LAS float*)(L + RS_LDS_OFF) + ui * 256 + wr * 64 + fr;
        f32x4 wuA[2][3], wgA[2][3], buA[2], bgA[2];
#pragma unroll
        for (int n = 0; n < 2; ++n) {
            const int f0 = u.pn * 128 + wc * 32 + 8 * fq + 4 * n;
#pragma unroll
            for (int j = 0; j < 3; ++j) { wuA[n][j] = *(const f32x4*)(cw + (size_t)j * F2 + f0); wgA[n][j] = *(const f32x4*)(cw + (size_t)j * F2 + FF + f0); }
            buA[n] = *(const f32x4*)(cb + f0); bgA[n] = *(const f32x4*)(cb + FF + f0);
        }
#pragma unroll
        for (int n = 0; n < 2; ++n) {
            const int f0 = u.pn * 128 + wc * 32 + 8 * fq + 4 * n;
            f32x4 wu[3], wg[3];
#pragma unroll
            for (int j = 0; j < 3; ++j) { wu[j] = wuA[n][j]; wg[j] = wgA[n][j]; }
            const f32x4 bu = buA[n], bg = bgA[n];
#pragma unroll
            for (int ai = 0; ai < 2; ++ai) {
                const int rowb = u.pm * 256 + ai * 128 + wr * 64;
                f32x4 U[4], G[4];
#pragma unroll
                for (int m = 0; m < 4; ++m) { const float s_ = tab[ai * 128 + m * 16]; U[m] = acc[ai][0][m][n] * s_; G[m] = acc[ai][1][m][n] * s_; }
                if (fr < 2) { bf16_t* ep = edge + ((size_t)(rowb >> 6) * 4 + fr) * F2 + u.pn * 256 + wc * 32 + 8 * fq + 4 * n;
                    u32x2 a; a.x = pack_bf16(U[0][0], U[0][1]); a.y = pack_bf16(U[0][2], U[0][3]); *(u32x2*)ep = a;
                    u32x2 c; c.x = pack_bf16(G[0][0], G[0][1]); c.y = pack_bf16(G[0][2], G[0][3]); *(u32x2*)(ep + 128) = c; }
                if (fr >= 14) { bf16_t* ep = edge + ((size_t)(rowb >> 6) * 4 + (fr - 12)) * F2 + u.pn * 256 + wc * 32 + 8 * fq + 4 * n;
                    u32x2 a; a.x = pack_bf16(U[3][0], U[3][1]); a.y = pack_bf16(U[3][2], U[3][3]); *(u32x2*)ep = a;
                    u32x2 c; c.x = pack_bf16(G[3][0], G[3][1]); c.y = pack_bf16(G[3][2], G[3][3]); *(u32x2*)(ep + 128) = c; }
#pragma unroll
                for (int m = 0; m < 4; ++m) {
                    float o[4];
#pragma unroll
                    for (int e = 0; e < 4; ++e) {
                        const float pu_s = rotr1(U[m][e]), pg_s = rotr1(G[m][e]), nu_s = rotl1(U[m][e]), ng_s = rotl1(G[m][e]);
                        const float pu_x = rotr1(U[m > 0 ? m - 1 : 0][e]), pg_x = rotr1(G[m > 0 ? m - 1 : 0][e]);
                        const float nu_x = rotl1(U[m < 3 ? m + 1 : 3][e]), ng_x = rotl1(G[m < 3 ? m + 1 : 3][e]);
                        const float pu = fr == 0 ? pu_x : pu_s, pg = fr == 0 ? pg_x : pg_s, nu = fr == 15 ? nu_x : nu_s, ng = fr == 15 ? ng_x : ng_s;
                        const float yu = bu[e] + pu * wu[0][e] + U[m][e] * wu[1][e] + nu * wu[2][e];
                        const float yg = bg[e] + pg * wg[0][e] + G[m][e] * wg[1][e] + ng * wg[2][e];
                        o[e] = yu * gelu_tanh(yg);
                    }
                    const bool edge_row = (m == 0 && fr == 0) || (m == 3 && fr == 15);
                    if (!edge_row) { u32x2 w; w.x = pack_bf16(o[0], o[1]); w.y = pack_bf16(o[2], o[3]); *(u32x2*)(O + (size_t)(rowb + m * 16 + fr) * FF + f0) = w; }
                }
            }
        }
    }
};
DI void ffn_fix_phase(const bf16_t* __restrict__ edge, bf16_t* __restrict__ Oo, const float* __restrict__ cw, const float* __restrict__ cb, int T) {
    constexpr int NCH = FF / 8;
    const int total = (T / 64) * 2 * NCH;
    for (int it = blockIdx.x * NTHR + otid(); it < total; it += gridDim.x * NTHR) {
        const int fc = it % NCH, rs = it / NCH, side = rs & 1, blk = rs >> 1, f0 = fc * 8;
        const int t = blk * 64 + (side ? 63 : 0), ts = t & (SEQ - 1);
        const int cu = 256 * (f0 >> 7) + (f0 & 127);
        const bf16_t* eb = edge + (size_t)blk * 4 * F2 + cu;
        const bf16_t* pp = side ? eb + 2 * F2 : eb - F2;
        const bf16_t* cp = side ? eb + 3 * F2 : eb;
        const bf16_t* np = side ? eb + 4 * F2 : eb + F2;
        const bool pz = (side == 0 && ts == 0), nz = (side == 1 && ts == SEQ - 1);
        float pu[8], pg[8], cu_[8], cg_[8], nu[8], ng[8];
        if (pz) {
#pragma unroll
            for (int e = 0; e < 8; ++e) { pu[e] = 0.f; pg[e] = 0.f; }
        } else { unpack8(*(const u32x4*)pp, pu); unpack8(*(const u32x4*)(pp + 128), pg); }
        unpack8(*(const u32x4*)cp, cu_); unpack8(*(const u32x4*)(cp + 128), cg_);
        if (nz) {
#pragma unroll
            for (int e = 0; e < 8; ++e) { nu[e] = 0.f; ng[e] = 0.f; }
        } else { unpack8(*(const u32x4*)np, nu); unpack8(*(const u32x4*)(np + 128), ng); }
        float o[8];
#pragma unroll
        for (int e = 0; e < 8; ++e) {
            const float yu = cb[f0 + e] + pu[e] * cw[f0 + e] + cu_[e] * cw[F2 + f0 + e] + nu[e] * cw[2 * F2 + f0 + e];
            const float yg = cb[FF + f0 + e] + pg[e] * cw[FF + f0 + e] + cg_[e] * cw[F2 + FF + f0 + e] + ng[e] * cw[2 * F2 + FF + f0 + e];
            o[e] = yu * gelu_tanh(yg);
        }
        *(bf16x8*)(Oo + (size_t)t * FF + f0) = pack8(o);
    }
}
template <class Epi> DI void run_gemm(LAS unsigned char* L, const bf16_t* A, const bf16_t* Bt, int M, int N, int K, const Epi& E) {
    pg8::Gemm g{A, Bt, M, N, K}; pg8::StaticOrder S; S.init(M, N, (int)gridDim.x, (int)blockIdx.x);
    if constexpr (Epi::NEEDS_RS) {
        const int tid = otid(), row = tid >> 1, hf = tid & 1;
        LAS float* tab = (LAS float*)(L + RS_LDS_OFF);
        pg8::Unit u;
        int nun = 0;
        while (nun < RS_MAX_UNITS && S.next(nun, u)) ++nun;
        for (int i0 = 0; i0 < nun; i0 += 4) {
            f32x4 a[4], c[4];
#pragma unroll
            for (int k = 0; k < 4; ++k) { const int i = i0 + k < nun ? i0 + k : nun - 1; S.next(i, u);
                const float* sp = E.ss + (size_t)(u.pm * 256 + row) * 16 + 8 * hf; a[k] = *(const f32x4*)sp; c[k] = *(const f32x4*)(sp + 4); }
#pragma unroll
            for (int k = 0; k < 4; ++k) {
                float s = ((a[k][0] + a[k][1]) + (a[k][2] + a[k][3])) + ((c[k][0] + c[k][1]) + (c[k][2] + c[k][3]));
                s += shx(s, 1);
                if (hf == 0 && i0 + k < nun) tab[(i0 + k) * 256 + row] = rsqrtf(s * (1.0f / D) + 1e-6f);
            }
        }
        __syncthreads();
    }
    pg8::gemm_phase<Epi, pg8::StaticOrder>(L, g, S, E);
}

DI void prep_matrix(LAS unsigned char* L, const float* W, int Kd, int Nd, const float* gain, bf16_t* WT, int sa0, int sa1, int sb0, int sb1, float cscale, int& boff, bool ffn_perm = false, int rot0 = 0, int rot1 = 0, int rhd = 64) {
    LAS float* tile = (LAS float*)L;
    const int tid = otid(), tn = Nd / 256, nt = (Kd / 64) * tn, G = (int)gridDim.x;
    const int first = ((int)blockIdx.x + G - (boff % G)) % G;
    boff += nt;
    for (int t = first; t < nt; t += G) {
        const int k0 = (t / tn) * 64, n0 = (t % tn) * 256;
        f32x4 v[8];
#pragma unroll
        for (int i = 0; i < 8; ++i) { const int idx = tid + NTHR * i, k = idx >> 6, c4 = idx & 63; v[i] = *(const f32x4*)(W + (size_t)(k0 + k) * Nd + n0 + 4 * c4); }
        __syncthreads();
#pragma unroll
        for (int i = 0; i < 8; ++i) {
            const int idx = tid + NTHR * i, k = idx >> 6, c4 = idx & 63;
            const float gk = gain ? gain[k0 + k] : 1.0f;
#pragma unroll
            for (int q = 0; q < 4; ++q) {
                const int col = n0 + 4 * c4 + q;
                float x = v[i][q] * gk;
                if ((col >= sa0 && col < sa1) || (col >= sb0 && col < sb1)) x *= cscale;
                tile[k * 257 + 4 * c4 + q] = x;
            }
        }
        __syncthreads();
#pragma unroll
        for (int j = 0; j < 4; ++j) {
            const int item = tid + NTHR * j, n = item >> 3, ch = item & 7;
            u32x4 w;
            w.x = pack_bf16(tile[(ch * 8 + 0) * 257 + n], tile[(ch * 8 + 1) * 257 + n]);
            w.y = pack_bf16(tile[(ch * 8 + 2) * 257 + n], tile[(ch * 8 + 3) * 257 + n]);
            w.z = pack_bf16(tile[(ch * 8 + 4) * 257 + n], tile[(ch * 8 + 5) * 257 + n]);
            w.w = pack_bf16(tile[(ch * 8 + 6) * 257 + n], tile[(ch * 8 + 7) * 257 + n]);
            int orow = n0 + n;
            if (orow >= rot0 && orow < rot1) { const int c = orow - rot0, d = c % rhd, hf = rhd >> 1; orow = rot0 + (c - d) + (d < hf ? 2 * d : 2 * (d - hf) + 1); }
            if (ffn_perm) { const int gate = orow >= FF, f = gate ? orow - FF : orow; orow = 256 * (f >> 7) + 128 * gate + (f & 127); }
            *(u32x4*)(WT + (size_t)orow * Kd + k0 + ch * 8) = w;
        }
    }
    __syncthreads();
}
DI void sincos_d(double a, float& c, float& s) {
    const double TWO_PI = 6.283185307179586476925286766559;
    const double k = __builtin_rint(a / TWO_PI);
    const double r = __builtin_fma(-k, TWO_PI, a);
    const double x = r * r;
    const double SC[14] = {1.0, -0.16666666666666666, 0.008333333333333333, -0.0001984126984126984, 2.7557319223985893e-06, -2.505210838544172e-08, 1.6059043836821613e-10, -7.647163731819816e-13, 2.8114572543455206e-15, -8.22063524662433e-18, 1.9572941063391263e-20, -3.868170170630684e-23, 6.446950284384474e-26, -9.183689863795546e-29};
    const double CC[14] = {1.0, -0.5, 0.041666666666666664, -0.001388888888888889, 2.48015873015873e-05, -2.755731922398589e-07, 2.08767569878681e-09, -1.1470745597729725e-11, 4.779477332387385e-14, -1.5619206968586225e-16, 4.110317623312165e-19, -8.896791392450574e-22, 1.6117375710961184e-24, -2.4795962632247976e-27};
    double ps = SC[13], pc = CC[13];
#pragma unroll
    for (int n = 12; n >= 0; --n) { ps = __builtin_fma(ps, x, SC[n]); pc = __builtin_fma(pc, x, CC[n]); }
    c = (float)pc; s = (float)(ps * r);
}
DI void rope_tables(float2* r64, float2* r256) {
    const int gt = blockIdx.x * NTHR + otid(), nth = gridDim.x * NTHR;
    const double LN_THETA = 9.210340371976184;
    for (int idx = gt; idx < SEQ * 32; idx += nth) { const int pos = idx >> 5, i = idx & 31; const double inv = exp(-(double)i / 32.0 * LN_THETA); float c, s; sincos_d((double)pos * inv, c, s); r64[idx] = make_float2(c, s); }
    for (int idx = gt; idx < SEQ * 128; idx += nth) { const int pos = idx >> 7, i = idx & 127; const double inv = exp(-(double)i / 128.0 * LN_THETA); float c, s; sincos_d((double)pos * inv, c, s); r256[idx] = make_float2(c, s); }
}

DI void cvt_phase(const float* __restrict__ x, bf16_t* __restrict__ h, float* __restrict__ ss, int rows) {
    const int tid = otid(), wave = tid >> 6, lane = tid & 63;
    constexpr int RB = 4;
    for (int row0 = (blockIdx.x * 8 + wave) * RB; row0 < rows; row0 += gridDim.x * 8 * RB) {
        float4 v[RB][4];
#pragma unroll
        for (int r = 0; r < RB; ++r)
#pragma unroll
            for (int i = 0; i < 4; ++i) v[r][i] = ((const float4*)(x + (size_t)(row0 + r) * D))[i * 64 + lane];
#pragma unroll
        for (int r = 0; r < RB; ++r) {
            float s2 = 0.f;
#pragma unroll
            for (int i = 0; i < 4; ++i) s2 += v[r][i].x * v[r][i].x + v[r][i].y * v[r][i].y + v[r][i].z * v[r][i].z + v[r][i].w * v[r][i].w;
            s2 = wave_sum(s2);
            if (lane < 4) *(f32x4*)(ss + (size_t)(row0 + r) * 16 + 4 * lane) = (f32x4){lane == 0 ? s2 : 0.f, 0.f, 0.f, 0.f};
#pragma unroll
            for (int i = 0; i < 4; ++i) { uint2 w; w.x = pack_bf16(v[r][i].x, v[r][i].y); w.y = pack_bf16(v[r][i].z, v[r][i].w); *(uint2*)(h + (size_t)(row0 + r) * D + (i * 64 + lane) * 4) = w; }
        }
    }
}
DI void final_norm_phase(const bf16_t* __restrict__ h, const float* __restrict__ ss, float* __restrict__ out, const float* __restrict__ g, int rows) {
    const int tid = otid(), wave = tid >> 6, lane = tid & 63;
    constexpr int RB = 8;
    float gg[16];
#pragma unroll
    for (int i = 0; i < 4; ++i) { const float4 a = ((const float4*)g)[lane * 4 + i]; gg[4 * i] = a.x; gg[4 * i + 1] = a.y; gg[4 * i + 2] = a.z; gg[4 * i + 3] = a.w; }
    for (int row0 = (blockIdx.x * 8 + wave) * RB; row0 < rows; row0 += gridDim.x * 8 * RB) {
        u32x4 v[RB][2]; float sp[RB];
#pragma unroll
        for (int r = 0; r < RB; ++r) {
            const bf16_t* hp = h + (size_t)(row0 + r) * D + lane * 16;
            v[r][0] = *(const u32x4*)hp; v[r][1] = *(const u32x4*)(hp + 8);
            sp[r] = ss[(size_t)(row0 + r) * 16 + (lane & 15)];
        }
#pragma unroll
        for (int r = 0; r < RB; ++r) {
            float s = sp[r]; s += shx(s, 1); s += shx(s, 2); s += shx(s, 4); s += shx(s, 8);
            const float rstd = rsqrtf(s * (1.0f / D) + 1e-6f);
            float f[16]; unpack8(v[r][0], f); unpack8(v[r][1], f + 8);
            float* op = out + (size_t)(row0 + r) * D + lane * 16;
#pragma unroll
            for (int i = 0; i < 4; ++i) { float4 o; o.x = f[4 * i] * rstd * gg[4 * i]; o.y = f[4 * i + 1] * rstd * gg[4 * i + 1]; o.z = f[4 * i + 2] * rstd * gg[4 * i + 2]; o.w = f[4 * i + 3] * rstd * gg[4 * i + 3]; ((float4*)op)[i] = o; }
        }
    }
}

DI void rotary_phase(bf16_t* P, int T, int ld, int col0, int nheads, int hd, const float2* __restrict__ tab) {
    const int half = hd >> 1, cpr = half >> 3, per_tok = nheads * cpr;
    const int total = T * per_tok, stride = gridDim.x * NTHR;
    for (int it0 = blockIdx.x * NTHR + otid(); it0 < total; it0 += 2 * stride) {
        bf16_t* base[2]; u32x4 a[2], bb[2]; float4 cs[2][4];
#pragma unroll
        for (int u = 0; u < 2; ++u) {
            const int it = (it0 + u * stride < total) ? it0 + u * stride : it0;
            const int tok = it / per_tok, r = it - tok * per_tok, hh = r / cpr, ch = r - hh * cpr, pos = tok & (SEQ - 1);
            base[u] = P + (size_t)tok * ld + col0 + hh * hd + ch * 8;
            a[u] = *(const u32x4*)base[u]; bb[u] = *(const u32x4*)(base[u] + half);
            const float4* tp = (const float4*)(tab + (size_t)pos * half + ch * 8);
#pragma unroll
            for (int j = 0; j < 4; ++j) cs[u][j] = tp[j];
        }
#pragma unroll
        for (int u = 0; u < 2; ++u) {
            u32x4 oa, ob;
#pragma unroll
            for (int j = 0; j < 4; ++j) {
                const float4 c = cs[u][j];
                const float x1l = bf_lo(a[u][j]), x1h = bf_hi(a[u][j]), x2l = bf_lo(bb[u][j]), x2h = bf_hi(bb[u][j]);
                oa[j] = pack_bf16(x1l * c.x - x2l * c.y, x1h * c.z - x2h * c.w);
                ob[j] = pack_bf16(x1l * c.y + x2l * c.x, x1h * c.w + x2h * c.z);
            }
            if (u == 0 || it0 + stride < total) { *(u32x4*)base[u] = oa; *(u32x4*)(base[u] + half) = ob; }
        }
    }
}

constexpr int ATT_RSV = 192;
constexpr int ATT_RPB_OFF = 64  , ATT_V_OFF = 16384, ATT_V_BYTES = 32 * ATT_RSV, ATT_W_BYTES = ATT_V_BYTES + 4096  ;
DI int crow(int reg, int h) { return (reg & 3) + 8 * (reg >> 2) + 4 * h; }

struct NaMask { LAS float* rp; int e0, b0; DI float operator()(int ic, float s) const { const float bias = rp[b0 + ic]; return (unsigned)(e0 + ic) < 16u ? s + bias : -1e30f; } };
struct DilMask { int e0; DI float operator()(int ic, float s) const { return (unsigned)(e0 + ic) <= 128u ? s : -1e30f; } };
struct DilMaskEdge { int e0, m0h, Lm; DI float operator()(int ic, float s) const { const bool ok = ((unsigned)(e0 + ic) <= 128u) && ((unsigned)(m0h + ic) < (unsigned)Lm); return ok ? s : -1e30f; } };

DI f32x16 attn_scores(LAS unsigned char* LQ, int lane, const bf16x8 (&kf)[4]) {
    f32x16 S;
#pragma unroll
    for (int i = 0; i < 16; ++i) S[i] = 0.f;
#pragma unroll
    for (int c = 0; c < 4; ++c) S = mfma32(kf[c], lds_r128(LQ, c * 1024 + lane * 16), S);
    return S;
}
template <class MaskF>
DI void attn_rest(const f32x16& S, LAS unsigned char* LV, int lane, f32x16& O0, f32x16& O1, float& m_run, float& l_run, const MaskF& maskf) {
    const int h = lane >> 5;
    float sv[16]; float mx = -1e30f;
#pragma unroll
    for (int r = 0; r < 16; ++r) { sv[r] = maskf((r & 3) + 8 * (r >> 2), S[r]); mx = fmaxf(mx, sv[r]); }
    mx = fmaxf(mx, shx(mx, 32));
    if (__builtin_amdgcn_ballot_w64(mx > m_run) != 0ull) {
        const float mn = fmaxf(m_run, mx);
        const float alpha = fexp2(m_run - mn);
        m_run = mn; l_run *= alpha;
#pragma unroll
        for (int i = 0; i < 16; ++i) { O0[i] *= alpha; O1[i] *= alpha; }
    }
    float ps = 0.f;
#pragma unroll
    for (int r = 0; r < 16; ++r) { const float p = fexp2(sv[r] - m_run); sv[r] = p; ps += p; }
    l_run += ps;
    const int i16 = lane & 15, q4 = i16 >> 2, p4 = i16 & 3, blk = (lane >> 4) & 1;
#pragma unroll
    for (int s = 0; s < 2; ++s) {
        const bf16x8 pf = pack8(&sv[8 * s]);
        const int r0 = 16 * s + 4 * h + q4, cb = 2 * (16 * blk + 4 * p4);
        const s16x4 lo0 = lds_tr(LV, r0 * ATT_RSV + cb), hi0 = lds_tr(LV, (r0 + 8) * ATT_RSV + cb);
        const s16x4 lo1 = lds_tr(LV, r0 * ATT_RSV + 64 + cb), hi1 = lds_tr(LV, (r0 + 8) * ATT_RSV + 64 + cb);
        O0 = mfma32(cat4(lo0, hi0), pf, O0);
        O1 = mfma32(cat4(lo1, hi1), pf, O1);
    }
}
DI void attn_load_k(const bf16_t* P, size_t tokbase, int ld, int kcol, int Dk, int rD, int Lm, int m0, int lane, bf16x8 (&kn)[4]) {
    const int h = lane >> 5;
    int m = m0 + (lane & 31); m = m < 0 ? 0 : (m > Lm - 1 ? Lm - 1 : m);
    const bf16_t* kp = P + (tokbase + (size_t)(Dk * m + rD)) * ld + kcol + 8 * h;
#pragma unroll
    for (int c = 0; c < 4; ++c) kn[c] = *(const bf16x8*)(kp + 16 * c);
}
DI void attn_load_v(const bf16_t* P, size_t tokbase, int ld, int vcol, int Dk, int rD, int Lm, int m0, int lane, bf16x8 (&vn)[4]) {
#pragma unroll
    for (int it = 0; it < 4; ++it) { int m = m0 + it * 8 + (lane >> 3); m = m < 0 ? 0 : (m > Lm - 1 ? Lm - 1 : m);
        vn[it] = *(const bf16x8*)(P + (tokbase + (size_t)(Dk * m + rD)) * ld + vcol + (lane & 7) * 8); }
}
DI void attn_store_v(LAS unsigned char* LV, int lane, const bf16x8 (&vn)[4]) {
    asm volatile("" ::: "memory");
#pragma unroll
    for (int it = 0; it < 4; ++it) lds_w128(LV, (it * 8 + (lane >> 3)) * ATT_RSV + (lane & 7) * 16, vn[it]);
    __builtin_amdgcn_wave_barrier();
    asm volatile("" ::: "memory");
}
DI void attn_finish(bf16_t* orow, int lane, const f32x16& O0, const f32x16& O1, float l_run) {
    const int h = lane >> 5;
    const float lt = l_run + shx(l_run, 32);
    const float inv = 1.0f / lt;
#pragma unroll
    for (int g = 0; g < 4; ++g) {
        uint2 w0, w1;
        w0.x = pack_bf16(O0[4 * g] * inv, O0[4 * g + 1] * inv); w0.y = pack_bf16(O0[4 * g + 2] * inv, O0[4 * g + 3] * inv);
        w1.x = pack_bf16(O1[4 * g] * inv, O1[4 * g + 1] * inv); w1.y = pack_bf16(O1[4 * g + 2] * inv, O1[4 * g + 3] * inv);
        *(uint2*)(orow + 8 * g + 4 * h) = w0;
        *(uint2*)(orow + 32 + 8 * g + 4 * h) = w1;
    }
}
struct NaDesc {
    const bf16_t* P; size_t tokbase; LAS float* rp; int lane, kcol, vcol, rsA, c0, qr, qc, rs, cs;
    DI void loadk(int t, bf16x8 (&kn)[4]) const { attn_load_k(P, tokbase, EIN, kcol, 1, 0, SEQ, (rsA + t) * 64 + c0, lane, kn); }
    DI void loadv(int t, bf16x8 (&vn)[4]) const { attn_load_v(P, tokbase, EIN, vcol, 1, 0, SEQ, (rsA + t) * 64 + c0, lane, vn); }
    DI void rest(int t, const f32x16& S, LAS unsigned char* LV, int ln, f32x16& O0, f32x16& O1, float& m_run, float& l_run) const { attn_rest(S, LV, ln, O0, O1, m_run, l_run, mask(t)); }
    DI NaMask mask(int t) const { const int kr = rsA + t, h4 = 4 * (lane >> 5); const bool rowok = (kr >= rs) && (kr < rs + 8); return NaMask{rp, rowok ? c0 - cs + h4 : (1 << 20), (kr - qr + 7) * 31 + c0 - qc + 15 + h4}; }
};
struct DilDesc {
    const bf16_t* P; size_t tokbase; int lane, kcol, vcol, mblk, r, tq;
    DI static int sh_of(int T) { return T < 20 ? 0 : (T < 28 ? 2 : 4); }
    DI static int tt_of(int T) { return T < 20 ? T : (T < 28 ? T - 20 : T - 28); }
    DI int m0_of(int T) const { const int sh = sh_of(T); return ((512 * mblk) >> sh) - 64 + 32 * tt_of(T); }
    DI void loadk(int T, bf16x8 (&kn)[4]) const { const int sh = sh_of(T); attn_load_k(P, tokbase, EIN, kcol, 1 << sh, r & ((1 << sh) - 1), SEQ >> sh, m0_of(T), lane, kn); }
    DI void loadv(int T, bf16x8 (&vn)[4]) const { const int sh = sh_of(T); attn_load_v(P, tokbase, EIN, vcol, 1 << sh, r & ((1 << sh) - 1), SEQ >> sh, m0_of(T), lane, vn); }
    DI void rest(int T, const f32x16& S, LAS unsigned char* LV, int ln, f32x16& O0, f32x16& O1, float& m_run, float& l_run) const {
        if (is_edge(T)) attn_rest(S, LV, ln, O0, O1, m_run, l_run, mask_edge(T)); else attn_rest(S, LV, ln, O0, O1, m_run, l_run, mask(T)); }
    DI DilMask mask(int T) const { const int sh = sh_of(T); return DilMask{m0_of(T) - (tq >> sh) + 64 + 4 * (lane >> 5)}; }
    DI DilMaskEdge mask_edge(int T) const { const int sh = sh_of(T), h4 = 4 * (lane >> 5); return DilMaskEdge{m0_of(T) - (tq >> sh) + 64 + h4, m0_of(T) + h4, SEQ >> sh}; }
    DI bool is_edge(int T) const { const int m0 = m0_of(T); return (m0 < 0) || (m0 + 32 > (SEQ >> sh_of(T))); }
};
template <class Desc>
DI void attn_loop(const Desc& d, int ntiles, const bf16x8 (&qf)[4], LAS unsigned char* LV, int lane, bf16_t* orow) {
    LAS unsigned char* LQ = LV + ATT_V_BYTES;
    asm volatile("" ::: "memory");
#pragma unroll
    for (int c = 0; c < 4; ++c) lds_w128(LQ, c * 1024 + lane * 16, qf[c]);
    asm volatile("" ::: "memory");
    f32x16 O0, O1;
#pragma unroll
    for (int i = 0; i < 16; ++i) { O0[i] = 0.f; O1[i] = 0.f; }
    float m_run = -1e30f, l_run = 0.f;
    bf16x8 kA[4], kB[4], vN[4];
    const int tl = ntiles - 1;
    d.loadk(0, kA); d.loadv(0, vN); d.loadk(1 < tl ? 1 : tl, kB);
#pragma unroll 1
    for (int t = 0; t + 1 < ntiles; t += 2) {
        const f32x16 Sa = attn_scores(LQ, lane, kA);
        d.loadk(t + 2 < tl ? t + 2 : tl, kA);
        attn_store_v(LV, lane, vN);
        d.loadv(t + 1, vN);
        d.rest(t, Sa, LV, lane, O0, O1, m_run, l_run);
        const f32x16 Sb = attn_scores(LQ, lane, kB);
        d.loadk(t + 3 < tl ? t + 3 : tl, kB);
        attn_store_v(LV, lane, vN);
        d.loadv(t + 2 < tl ? t + 2 : tl, vN);
        d.rest(t + 1, Sb, LV, lane, O0, O1, m_run, l_run);
    }
    if (ntiles & 1) {
        const f32x16 Sa = attn_scores(LQ, lane, kA);
        attn_store_v(LV, lane, vN);
        d.rest(tl, Sa, LV, lane, O0, O1, m_run, l_run);
    }
    attn_finish(orow, lane, O0, O1, l_run);
}
DI void na_item(int item, const bf16_t* P, bf16_t* Oo, LAS float* rpbL, LAS unsigned char* LV, int lane) {
    const int cb = item & 3, rp = (item >> 2) & 31, head = (item >> 7) & 7, seq = item >> 10;
    const size_t tokbase = (size_t)seq * SEQ;
    const int h = lane >> 5, j = lane & 31, qr = 2 * rp + (j >> 4), qc = 16 * cb + (j & 15), tq = qr * 64 + qc;
    bf16x8 qf[4];
    { const bf16_t* qp = P + (tokbase + tq) * EIN + head * 64 + 8 * h;
#pragma unroll
      for (int c = 0; c < 4; ++c) qf[c] = *(const bf16x8*)(qp + 16 * c); }
    int rs = qr - 4; rs = rs < 0 ? 0 : (rs > 56 ? 56 : rs);
    int cs = qc - 8; cs = cs < 0 ? 0 : (cs > 48 ? 48 : cs);
    int rsA = 2 * rp - 4; rsA = rsA < 0 ? 0 : (rsA > 56 ? 56 : rsA);
    int rsB = 2 * rp - 3; rsB = rsB < 0 ? 0 : (rsB > 56 ? 56 : rsB);
    const int c0 = cb == 0 ? 0 : (cb == 1 ? 8 : (cb == 2 ? 24 : 32));
    const NaDesc d{P, tokbase, rpbL + head * 465, lane, 512 + head * 64, 1024 + head * 64, rsA, c0, qr, qc, rs, cs};
    attn_loop(d, rsB + 8 - rsA, qf, LV, lane, Oo + (tokbase + tq) * D + head * 64);
}
DI void dil_item(int item, const bf16_t* P, bf16_t* Oo, LAS unsigned char* LV, int lane) {
    const int mblk = item & 7, r = (item >> 3) & 15, head = (item >> 7) & 7, seq = item >> 10;
    const size_t tokbase = (size_t)seq * SEQ;
    const int h = lane >> 5, tq = 16 * (32 * mblk + (lane & 31)) + r;
    bf16x8 qf[4];
    { const bf16_t* qp = P + (tokbase + tq) * EIN + 1536 + head * 64 + 8 * h;
#pragma unroll
      for (int c = 0; c < 4; ++c) qf[c] = *(const bf16x8*)(qp + 16 * c); }
    const DilDesc d{P, tokbase, lane, 2048 + head * 64, 2560 + head * 64, mblk, r, tq};
    attn_loop(d, 33, qf, LV, lane, Oo + (tokbase + tq) * D + 512 + head * 64);
}
DI void attn_phase(LAS unsigned char* L, const bf16_t* P, bf16_t* Oo, const float* rpb, int nseq) {
    LAS float* rpbL = (LAS float*)(L + ATT_RPB_OFF);
    const int tid = otid();
    for (int i = tid; i < 8 * 465; i += NTHR) rpbL[i] = rpb[i] * LOG2E;
    __syncthreads();
    const int wave = tid >> 6, lane = tid & 63;
    LAS unsigned char* LV = L + ATT_V_OFF + wave * ATT_W_BYTES;
    const int nitems = nseq * 1024, nw = gridDim.x * 8;
    for (int it = vblock() * 8 + wave; it < 2 * nitems; it += nw) {
        if (it < nitems) na_item(it, P, Oo, rpbL, LV, lane);
        else dil_item(it - nitems, P, Oo, LV, lane);
    }
    __syncthreads();
}

DI void conv_phase(const bf16_t* __restrict__ A, bf16_t* __restrict__ Oo, const float* __restrict__ cw, const float* __restrict__ cb, int T) {
    constexpr int TB = 8, NCH = FF / 8;
    const int total = (T / TB) * NCH;
    for (int it = blockIdx.x * NTHR + otid(); it < total; it += gridDim.x * NTHR) {
        const int tb = it / NCH, fc = it - tb * NCH, t0 = tb * TB, f0 = fc * 8;
        const bf16_t* ap = A + (size_t)t0 * F2 + f0;
        const bool first = (t0 & (SEQ - 1)) == 0, last = ((t0 + TB) & (SEQ - 1)) == 0;
        u32x4 ru[TB + 2], rg[TB + 2];
#pragma unroll
        for (int r = 0; r < TB + 2; ++r) {
            const bool zero = (r == 0 && first) || (r == TB + 1 && last);
            const bf16_t* rp = ap + (ptrdiff_t)(zero ? 0 : r - 1) * F2;
            ru[r] = *(const u32x4*)rp; rg[r] = *(const u32x4*)(rp + FF);
            if (zero) { ru[r] = (u32x4){0u, 0u, 0u, 0u}; rg[r] = (u32x4){0u, 0u, 0u, 0u}; }
        }
        float wu[3][8], wg[3][8], bu[8], bg[8];
#pragma unroll
        for (int j = 0; j < 3; ++j)
#pragma unroll
            for (int e = 0; e < 8; e += 4) { const float4 a = *(const float4*)(cw + (size_t)j * F2 + f0 + e), c = *(const float4*)(cw + (size_t)j * F2 + FF + f0 + e);
                wu[j][e] = a.x; wu[j][e + 1] = a.y; wu[j][e + 2] = a.z; wu[j][e + 3] = a.w; wg[j][e] = c.x; wg[j][e + 1] = c.y; wg[j][e + 2] = c.z; wg[j][e + 3] = c.w; }
#pragma unroll
        for (int e = 0; e < 8; e += 4) { const float4 a = *(const float4*)(cb + f0 + e), c = *(const float4*)(cb + FF + f0 + e);
            bu[e] = a.x; bu[e + 1] = a.y; bu[e + 2] = a.z; bu[e + 3] = a.w; bg[e] = c.x; bg[e + 1] = c.y; bg[e + 2] = c.z; bg[e + 3] = c.w; }
        float pu[8], pg[8], cu[8], cg_[8], nu[8], ng[8];
        unpack8(ru[0], pu); unpack8(rg[0], pg); unpack8(ru[1], cu); unpack8(rg[1], cg_);
#pragma unroll
        for (int r = 0; r < TB; ++r) {
            unpack8(ru[r + 2], nu); unpack8(rg[r + 2], ng);
            float o[8];
#pragma unroll
            for (int e = 0; e < 8; ++e) {
                const float yu = bu[e] + pu[e] * wu[0][e] + cu[e] * wu[1][e] + nu[e] * wu[2][e];
                const float yg = bg[e] + pg[e] * wg[0][e] + cg_[e] * wg[1][e] + ng[e] * wg[2][e];
                o[e] = yu * gelu_tanh(yg);
                pu[e] = cu[e]; pg[e] = cg_[e]; cu[e] = nu[e]; cg_[e] = ng[e];
            }
            *(bf16x8*)(Oo + (size_t)(t0 + r) * FF + f0) = pack8(o);
        }
    }
}

constexpr int RT_RSQ = 528, RT_RSV = 144;
constexpr int RT_OQ = 0, RT_OK = 64 * RT_RSQ, RT_OS = 2 * 64 * RT_RSQ, RT_OV = 3 * 64 * RT_RSQ  , RT_OVK = RT_OV + 2 * 64 * RT_RSV, RT_OP = RT_OVK + 64 * RT_RSV, RT_END = RT_OP + 64 * RT_RSV;
static_assert(RT_END <= LDS_BYTES - 16, "retention LDS");
DI float softplus_f(float x) { return x > 20.f ? x : log1pf(expf(x)); }
DI void ret_issue(const bf16_t* qg, const bf16_t* kg, const bf16_t* vg, size_t tok0, int tid, bf16x8 (&sq)[4], bf16x8 (&sk)[4], bf16x8& sv) {
#pragma unroll
    for (int i = 0; i < 4; ++i) { const int idx = tid + NTHR * i, row = idx >> 5, ch = idx & 31; const size_t o = (tok0 + row) * RIN + ch * 8; sq[i] = *(const bf16x8*)(qg + o); sk[i] = *(const bf16x8*)(kg + o); }
    { const int row = tid >> 3, ch = tid & 7; sv = *(const bf16x8*)(vg + (tok0 + row) * RIN + ch * 8); }
}
DI void ret_stage(LAS unsigned char* L, int tid, int vbuf, float kd, const bf16x8 (&sq)[4], const bf16x8 (&sk)[4], const bf16x8& sv) {
#pragma unroll
    for (int i = 0; i < 4; ++i) { const int idx = tid + NTHR * i, row = idx >> 5, ch = idx & 31; lds_w128(L, RT_OQ + row * RT_RSQ + ch * 16, sq[i]); lds_w128(L, RT_OK + row * RT_RSQ + ch * 16, sk[i]); }
    const int row = tid >> 3, ch = tid & 7;
    lds_w128(L, RT_OV + vbuf * 64 * RT_RSV + row * RT_RSV + ch * 16, sv);
    float f[8]; unpack8(__builtin_bit_cast(u32x4, sv), f);
#pragma unroll
    for (int e = 0; e < 8; ++e) f[e] *= kd;
    lds_w128(L, RT_OVK + row * RT_RSV + ch * 16, pack8(f));
}
DI void ret_phase(LAS unsigned char* L, const bf16_t* P, bf16_t* R, const float* lg2tab, int nseq) {
    const int tid = otid(), wave = __builtin_amdgcn_readfirstlane(tid >> 6), lane = tid & 63, l15 = lane & 15, quad = lane >> 4, q4 = l15 >> 2, p4 = l15 & 3;
    const int xb = wave & 3, wh = wave >> 2;
    for (int item = vblock(); item < nseq * 64; item += gridDim.x) {
        const int vs = item & 7, dir = (item >> 3) & 1, hh = (item >> 4) & 3, seq = item >> 6;
        const float lg2 = lg2tab[dir * 4 + hh];
        int oz = 0; asm volatile("" : "+v"(oz));
        const size_t tokbase = (size_t)seq * SEQ;
        const bf16_t* qg = P + hh * 256; const bf16_t* kg = P + 1024 + hh * 256; const bf16_t* vg = P + 2048 + hh * 512 + vs * 64;
        bf16_t* rout = R + (size_t)dir * TG * RMIX + hh * 512 + vs * 64;
        bf16x8 sq[4], sk[4], sv;
        ret_issue(qg, kg, vg, tokbase + (size_t)(dir ? 63 : 0) * 64, tid, sq, sk, sv);
        __syncthreads();
        { const unsigned z = (unsigned)oz; const u32x4 zz = {z, z, z, z};
          for (int i = tid; i < 64 * RT_RSQ / 16; i += NTHR) *(LAS u32x4*)(L + RT_OS + i * 16) = zz; }
        f32x4 st[8];
#pragma unroll
        for (int j = 0; j < 8; ++j) st[j] = (f32x4){0.f, 0.f, 0.f, 0.f};
        float qd[2][4];
#pragma unroll
        for (int t = 0; t < 2; ++t)
#pragma unroll
            for (int r = 0; r < 4; ++r) { const int q = (2 * wh + t) * 16 + 4 * quad + r + oz; qd[t][r] = fexp2(lg2 * (float)(dir ? 64 - q : q + 1)); }
        const float sd = fexp2(lg2 * 64.f);
        const float kdv = fexp2(lg2 * (float)(dir ? (tid >> 3) + oz : 63 - (tid >> 3) + oz));
        float dm[2][4];
#pragma unroll
        for (int t = 0; t < 2; ++t)
#pragma unroll
            for (int r = 0; r < 4; ++r) { const int q = (2 * wh + t) * 16 + l15 + oz, key = xb * 16 + 4 * quad + r; const int diff = dir ? key - q : q - key; const bool ok = dir ? (diff > 0) : (diff >= 0); dm[t][r] = ok ? fexp2(lg2 * (float)diff) : 0.f; }
        ret_stage(L, tid, 0, kdv, sq, sk, sv);
        __syncthreads();
#pragma unroll 1
        for (int step = 0; step < 64; ++step) {
            const int c = dir ? 63 - step : step, cur = step & 1;
            int lo_ = lane; asm volatile("" : "+v"(lo_));
            const int l15 = lo_ & 15, quad = lo_ >> 4, q4 = l15 >> 2, p4 = l15 & 3;
            if (step + 1 < 64) ret_issue(qg, kg, vg, tokbase + (size_t)(dir ? 62 - step : step + 1) * 64, tid, sq, sk, sv);
            bf16x8 qa[2][8];
#pragma unroll
            for (int s = 0; s < 8; ++s) {
                const int ko = (32 * s + 8 * quad) * 2;
                qa[0][s] = lds_r128(L, RT_OQ + ((2 * wh) * 16 + l15) * RT_RSQ + ko); qa[1][s] = lds_r128(L, RT_OQ + ((2 * wh + 1) * 16 + l15) * RT_RSQ + ko);
            }
            f32x4 s0 = (f32x4){0.f, 0.f, 0.f, 0.f}, s1 = s0;
#pragma unroll
            for (int hs = 0; hs < 2; ++hs) {
                bf16x8 xa[4];
#pragma unroll
                for (int s = 0; s < 4; ++s) xa[s] = lds_r128(L, RT_OK + (xb * 16 + l15) * RT_RSQ + (32 * (4 * hs + s) + 8 * quad) * 2);
#pragma unroll
                for (int s = 0; s < 4; ++s) { s0 = mfma16(xa[s], qa[0][4 * hs + s], s0); s1 = mfma16(xa[s], qa[1][4 * hs + s], s1); }
            }
#pragma unroll
            for (int t = 0; t < 2; ++t) {
                const f32x4 sx = t ? s1 : s0;
                const int q = (2 * wh + t) * 16 + l15, key0 = xb * 16 + 4 * quad;
                u32x2 w; w.x = pack_bf16(sx[0] * dm[t][0], sx[1] * dm[t][1]); w.y = pack_bf16(sx[2] * dm[t][2], sx[3] * dm[t][3]);
                *(LAS u32x2*)(L + RT_OP + q * RT_RSV + key0 * 2) = w;
            }
            f32x4 o0 = (f32x4){0.f, 0.f, 0.f, 0.f}, o1 = o0;
#pragma unroll
            for (int hs = 0; hs < 2; ++hs) {
                bf16x8 xa[4];
#pragma unroll
                for (int s = 0; s < 4; ++s) xa[s] = lds_r128(L, RT_OS + (xb * 16 + l15) * RT_RSQ + (32 * (4 * hs + s) + 8 * quad) * 2);
#pragma unroll
                for (int s = 0; s < 4; ++s) { o0 = mfma16(qa[0][4 * hs + s], xa[s], o0); o1 = mfma16(qa[1][4 * hs + s], xa[s], o1); }
            }
#pragma unroll
            for (int r = 0; r < 4; ++r) { o0[r] *= qd[0][r]; o1[r] *= qd[1][r]; }
#pragma unroll
            for (int j = 0; j < 8; ++j) st[j] *= sd;
#pragma unroll
            for (int s = 0; s < 2; ++s) {
                const int kr = 32 * s + 8 * quad + q4;
                const bf16x8 bv = cat4(lds_tr(L, RT_OVK + kr * RT_RSV + (xb * 16 + 4 * p4) * 2), lds_tr(L, RT_OVK + (kr + 4) * RT_RSV + (xb * 16 + 4 * p4) * 2));
#pragma unroll
                for (int hj = 0; hj < 2; ++hj) {
                    bf16x8 ak[4];
#pragma unroll
                    for (int j = 0; j < 4; ++j) { const int db = 8 * wh + 4 * hj + j; ak[j] = cat4(lds_tr(L, RT_OK + kr * RT_RSQ + (db * 16 + 4 * p4) * 2), lds_tr(L, RT_OK + (kr + 4) * RT_RSQ + (db * 16 + 4 * p4) * 2)); }
#pragma unroll
                    for (int j = 0; j < 4; ++j) st[4 * hj + j] = mfma16(ak[j], bv, st[4 * hj + j]);
                }
            }
            __syncthreads();
            if (step + 1 < 64) ret_stage(L, tid, cur ^ 1, kdv, sq, sk, sv);
#pragma unroll
            for (int s = 0; s < 2; ++s) {
                const int kr = 32 * s + 8 * quad + q4, ko = (32 * s + 8 * quad) * 2;
                const bf16x8 bv = cat4(lds_tr(L, RT_OV + cur * 64 * RT_RSV + kr * RT_RSV + (xb * 16 + 4 * p4) * 2), lds_tr(L, RT_OV + cur * 64 * RT_RSV + (kr + 4) * RT_RSV + (xb * 16 + 4 * p4) * 2));
                const bf16x8 a0 = lds_r128(L, RT_OP + ((2 * wh) * 16 + l15) * RT_RSV + ko), a1 = lds_r128(L, RT_OP + ((2 * wh + 1) * 16 + l15) * RT_RSV + ko);
                o0 = mfma16(a0, bv, o0); o1 = mfma16(a1, bv, o1);
            }
#pragma unroll
            for (int t = 0; t < 2; ++t)
#pragma unroll
                for (int r = 0; r < 4; ++r) {
                    const int q = (2 * wh + t) * 16 + 4 * quad + r;
                    const float val = t ? o1[r] : o0[r];
                    rout[(tokbase + (size_t)c * 64 + q) * RMIX + xb * 16 + l15] = (bf16_t)(pack_bf16(val, 0.f) & 0xffffu);
                }
#pragma unroll
            for (int j = 0; j < 8; ++j) { const int db = 8 * wh + j; u32x2 w; w.x = pack_bf16(st[j][0], st[j][1]); w.y = pack_bf16(st[j][2], st[j][3]);
                *(LAS u32x2*)(L + RT_OS + (xb * 16 + l15) * RT_RSQ + (db * 16 + 4 * quad) * 2) = w; }
            __syncthreads();
        }
    }
    __syncthreads();
}
DI void ret_combine_phase(const bf16_t* __restrict__ R, const bf16_t* __restrict__ P, bf16_t* __restrict__ Oo, int T) {
    const int tid = otid(), wave = tid >> 6, lane = tid & 63;
    const int stride = gridDim.x * 8;
    for (int it0 = blockIdx.x * 8 + wave; it0 < T * 4; it0 += 2 * stride) {
        u32x4 ra[2], rb[2], rg[2]; size_t off[2];
#pragma unroll
        for (int u = 0; u < 2; ++u) {
            const int it = (it0 + u * stride < T * 4) ? it0 + u * stride : it0, tok = it >> 2, hh = it & 3;
            off[u] = (size_t)tok * RMIX + hh * 512 + lane * 8;
            ra[u] = *(const u32x4*)(R + off[u]); rb[u] = *(const u32x4*)(R + (size_t)TG * RMIX + off[u]);
            rg[u] = *(const u32x4*)(P + (size_t)tok * RIN + 4096 + hh * 512 + lane * 8);
        }
#pragma unroll
        for (int u = 0; u < 2; ++u) {
            float a[8], c[8], g[8];
            unpack8(ra[u], a); unpack8(rb[u], c); unpack8(rg[u], g);
            float s = 0.f;
#pragma unroll
            for (int e = 0; e < 8; ++e) { a[e] += c[e]; s += a[e]; }
            const float mu = wave_sum(s) * (1.0f / 512.f);
            float v = 0.f;
#pragma unroll
            for (int e = 0; e < 8; ++e) { a[e] -= mu; v += a[e] * a[e]; }
            const float rstd = rsqrtf(wave_sum(v) * (1.0f / 512.f) + 1e-6f);
            float o[8];
#pragma unroll
            for (int e = 0; e < 8; ++e) { const float sg = g[e] / (1.0f + __expf(-g[e])); o[e] = sg * a[e] * rstd; }
            *(bf16x8*)(Oo + off[u]) = pack8(o);
        }
    }
}

#define XB_TMO      128
#define XB_XCNT(j)  (256  + 64 * (j))
#define XB_XSUB(j)  (1280 + 64 * (j))
#define XB_XGEN(j)  (2304 + 64 * (j))
#define XB_TOP      3328
#define XB_TOPGEN   3392
#define XCD_BAR_WORDS 3456
#define XB_SPIN_CAP (1u << 22)
DI unsigned xb_ld(unsigned* p)              { return __hip_atomic_load(p, __ATOMIC_RELAXED, __HIP_MEMORY_SCOPE_AGENT); }
DI unsigned xb_add(unsigned* p, unsigned v) { return __hip_atomic_fetch_add(p, v, __ATOMIC_RELAXED, __HIP_MEMORY_SCOPE_AGENT); }
DI unsigned xb_xcc_id() { return (unsigned)__builtin_amdgcn_s_getreg((3 << 11) | 20) & 0xFu; }
#define XB_SPIN(cond, bar) do { unsigned _sp = 0; while (cond) { __builtin_amdgcn_s_sleep(1); \
    if ((++_sp & 255u) == 0u) { if (xb_ld(&(bar)[XB_TMO])) break; if (_sp > XB_SPIN_CAP) { atomicAdd(&(bar)[XB_TMO], 1u); break; } } } } while (0)
struct XcdBarrier { unsigned* bar; unsigned x; volatile LAS unsigned* st; };
DI XcdBarrier xcd_barrier_post(unsigned* bar, volatile LAS unsigned* st) {
    XcdBarrier b; b.bar = bar; b.x = xb_xcc_id(); b.st = st;
    if (raw_tid() == 0) (void)xb_add(&bar[XB_XCNT(b.x)], 1u);
    return b;
}
DI void xcd_barrier_complete(unsigned* bar, unsigned x, unsigned& nloc, unsigned& nx) {
    const unsigned G = gridDim.x * gridDim.y * gridDim.z;
    unsigned sum, cnt, mine, sp = 0u;
    for (;;) {
        sum = 0u; cnt = 0u; mine = 0u;
#pragma unroll 1
        for (unsigned j = 0; j < 16; ++j) { const unsigned c = xb_ld(&bar[XB_XCNT(j)]); sum += c; cnt += (c > 0u) ? 1u : 0u; mine = (j == x) ? c : mine; }
        if (sum == G) break;
        __builtin_amdgcn_s_sleep(1);
        if ((++sp & 255u) == 0u) { if (xb_ld(&bar[XB_TMO])) break; if (sp > XB_SPIN_CAP) { atomicAdd(&bar[XB_TMO], 1u); break; } }
    }
    nloc = mine > 0u ? mine : 1u; nx = cnt > 0u ? cnt : 1u;
}
DI void xcd_barrier(const XcdBarrier& b) {
    asm volatile("s_waitcnt vmcnt(0)" ::: "memory");
    __syncthreads();
    if (raw_tid() == 0) {
        unsigned* bar = b.bar;
        __builtin_amdgcn_s_waitcnt(0);
        unsigned nloc = b.st[0], nx = b.st[1];
        if (nloc == 0u) { xcd_barrier_complete(bar, b.x, nloc, nx); b.st[0] = nloc; b.st[1] = nx; }
        const unsigned old = xb_add(&bar[XB_XSUB(b.x)], 1u);
        const unsigned gen = old / nloc;
        if (old + 1u == (gen + 1u) * nloc) {
            __builtin_amdgcn_fence(__ATOMIC_RELEASE, "agent");
            asm volatile("s_waitcnt vmcnt(0)" ::: "memory");
            const unsigned og = xb_add(&bar[XB_TOP], 1u);
            const unsigned tg = og / nx;
            if (og + 1u == (tg + 1u) * nx) xb_add(&bar[XB_TOPGEN], 1u);
            else XB_SPIN(xb_ld(&bar[XB_TOPGEN]) == tg, bar);
            __builtin_amdgcn_fence(__ATOMIC_ACQUIRE, "agent");
            xb_add(&bar[XB_XGEN(b.x)], 1u);
            asm volatile("s_waitcnt vmcnt(0)" ::: "memory");
        } else {
            XB_SPIN(xb_ld(&bar[XB_XGEN(b.x)]) == gen, bar);
            __builtin_amdgcn_fence(__ATOMIC_ACQUIRE, "agent");
            asm volatile("s_waitcnt vmcnt(0)" ::: "memory");
        }
    }
    __syncthreads();
}

typedef __attribute__((address_space(1))) unsigned char* gptr_t;
DI gptr_t ws_op(unsigned char* w) { gptr_t g = (gptr_t)w; asm volatile("" : "+s"(g)); return g; }
__global__ void __launch_bounds__(NTHR, 2) mega_fwd(Params p) {
    extern __shared__ __attribute__((aligned(16))) unsigned char shm[];
    LAS unsigned char* L = (LAS unsigned char*)shm;
    cg::grid_group grid = cg::this_grid();
    unsigned char* ws = p.ws;
    volatile LAS unsigned* bst = (volatile LAS unsigned*)(L + LDS_BYTES - 16);
    if (raw_tid() == 0) { bst[0] = 0u; bst[1] = 0u; }
    __syncthreads();
    const XcdBarrier xbar = xcd_barrier_post((unsigned*)(ws + WS_BAR), bst);
#define WSO(T, off) ((T*)(ws_op(ws) + (off)))
#define Win0   WSO(bf16_t, WS_WIN0)
#define Wout0  WSO(bf16_t, WS_WOUT0)
#define Wrin   WSO(bf16_t, WS_WRIN)
#define Wrout  WSO(bf16_t, WS_WROUT)
#define Wup    WSO(bf16_t, WS_WUP)
#define Wdn    WSO(bf16_t, WS_WDN)
#define rope64  WSO(float2, WS_ROPE64)
#define rope256 WSO(float2, WS_ROPE256)
#define SS     WSO(float, WS_SS)
#define H      WSO(bf16_t, WS_H)
#define P      WSO(bf16_t, WS_P)
#define O      WSO(bf16_t, WS_O)
#define R      WSO(bf16_t, WS_R)
    int boff = 0;
    prep_matrix(L, p.even_w_in, D, EIN, p.attn_norm, Win0, 0, 512, 1536, 2048, 0.125f * LOG2E, boff, false, 1536, 2560, 64);
    prep_matrix(L, p.even_w_out, D, D, nullptr, Wout0, 0, 0, 0, 0, 1.f, boff);
    prep_matrix(L, p.ret_w_in, D, RIN, p.attn_norm + D, Wrin, 0, 1024, 0, 0, 0.0625f, boff, false, 0, 2048, 256);
    prep_matrix(L, p.ret_w_out, RMIX, D, nullptr, Wrout, 0, 0, 0, 0, 1.f, boff);
    prep_matrix(L, p.ffn_w_up, D, F2, p.ffn_norm, Wup, 0, 0, 0, 0, 1.f, boff, true);
    prep_matrix(L, p.ffn_w_up + (size_t)D * F2, D, F2, p.ffn_norm + D, Wup + (size_t)F2 * D, 0, 0, 0, 0, 1.f, boff, true);
    prep_matrix(L, p.ffn_w_down, FF, D, nullptr, Wdn, 0, 0, 0, 0, 1.f, boff);
    prep_matrix(L, p.ffn_w_down + (size_t)FF * D, FF, D, nullptr, Wdn + (size_t)D * FF, 0, 0, 0, 0, 1.f, boff);
    rope_tables(rope64, rope256);
    if (blockIdx.x == 0 && raw_tid() < 8) WSO(float, WS_LG2)[raw_tid()] = -softplus_f((raw_tid() < 4 ? p.dec_f : p.dec_b)[raw_tid() & 3]) * LOG2E;
    grid.sync();

#pragma unroll 1
    for (int g = 0; g < NGRP; ++g) {
        const int nseq = g < 2 ? GSEQ : 4, T = nseq * SEQ;
        const float* xin = g < 2 ? p.xp + (size_t)g * TG * D : p.xs;
        float* xo = p.out + (size_t)g * TG * D;
        cvt_phase(xin, H, SS, T); xcd_barrier(xbar);
        run_gemm(L, H, Win0, T, EIN, D, EpiBf16{P, EIN, SS, L, rope64, 6, 10, 64}); xcd_barrier(xbar);
        attn_phase(L, P, O, p.na_rpb, nseq); xcd_barrier(xbar);
        run_gemm(L, O, Wout0, T, D, D, EpiRes<false>{H, nullptr, SS + 16 * (size_t)TG}); xcd_barrier(xbar);
        run_gemm(L, H, Wup, T, F2, D, EpiConv{O, SS + 16 * (size_t)TG, L, p.conv_w, p.conv_b, WSO(bf16_t, WS_EDGE)}); xcd_barrier(xbar);
        ffn_fix_phase(WSO(bf16_t, WS_EDGE), O, p.conv_w, p.conv_b, T); xcd_barrier(xbar);
        run_gemm(L, O, Wdn, T, D, FF, EpiRes<false>{H, nullptr, SS + 32 * (size_t)TG}); xcd_barrier(xbar);
        run_gemm(L, H, Wrin, T, RIN, D, EpiBf16{P, RIN, SS + 32 * (size_t)TG, L, rope256, 0, 8, 256}); xcd_barrier(xbar);
        ret_phase(L, P, R, WSO(float, WS_LG2), nseq); xcd_barrier(xbar);
        ret_combine_phase(R, P, O, T); xcd_barrier(xbar);
        run_gemm(L, O, Wrout, T, D, RMIX, EpiRes<false>{H, nullptr, SS + 48 * (size_t)TG}); xcd_barrier(xbar);
        run_gemm(L, H, Wup + (size_t)F2 * D, T, F2, D, EpiConv{O, SS + 48 * (size_t)TG, L, p.conv_w + 3 * F2, p.conv_b + F2, WSO(bf16_t, WS_EDGE)}); xcd_barrier(xbar);
        ffn_fix_phase(WSO(bf16_t, WS_EDGE), O, p.conv_w + 3 * F2, p.conv_b + F2, T); xcd_barrier(xbar);
        run_gemm(L, O, Wdn + (size_t)D * FF, T, D, FF, EpiRes<false>{H, nullptr, SS}); xcd_barrier(xbar);
        final_norm_phase(H, SS, xo, p.final_norm, T);
        if (g + 1 < NGRP) xcd_barrier(xbar);
    }
}

#undef Win0
#undef Wout0
#undef Wrin
#undef Wrout
#undef Wup
#undef Wdn
#undef rope64
#undef rope256
#undef SS
#undef H
#undef P
#undef O
#undef R
#undef WSO

extern "C" void kernel_launch(void* const* d_in, const int* in_sizes, int n_in, void* d_out, int out_size, void* d_ws, size_t ws_size, hipStream_t stream) {
    static int grid_blocks = 0;
    if (grid_blocks == 0) {
        int dev = 0, cus = 0, per_cu = 0;
        (void)hipGetDevice(&dev);
        (void)hipDeviceGetAttribute(&cus, hipDeviceAttributeMultiprocessorCount, dev);
        if (hipFuncSetAttribute((const void*)mega_fwd, hipFuncAttributeMaxDynamicSharedMemorySize, LDS_BYTES) != hipSuccess) fprintf(stderr, "kernel_launch: hipFuncSetAttribute failed\n");
        if (hipOccupancyMaxActiveBlocksPerMultiprocessor(&per_cu, (const void*)mega_fwd, NTHR, LDS_BYTES) != hipSuccess || per_cu < 1) { fprintf(stderr, "kernel_launch: occupancy query says %d\n", per_cu); per_cu = 1; }
        (void)hipGetLastError();
        grid_blocks = cus * 1;
        if (ws_size < WS_END) fprintf(stderr, "kernel_launch: workspace too small: %zu < %zu\n", ws_size, (size_t)WS_END);
    }
    Params p{};
    p.xp = (const float*)d_in[0]; p.xs = (const float*)d_in[1]; p.attn_norm = (const float*)d_in[2]; p.even_w_in = (const float*)d_in[3]; p.na_rpb = (const float*)d_in[4];
    p.even_w_out = (const float*)d_in[5]; p.ret_w_in = (const float*)d_in[6]; p.dec_f = (const float*)d_in[7]; p.dec_b = (const float*)d_in[8]; p.ret_w_out = (const float*)d_in[9];
    p.ffn_norm = (const float*)d_in[10]; p.ffn_w_up = (const float*)d_in[11]; p.conv_w = (const float*)d_in[12]; p.conv_b = (const float*)d_in[13]; p.ffn_w_down = (const float*)d_in[14];
    p.final_norm = (const float*)d_in[15];
    p.out = (float*)d_out; p.ws = (unsigned char*)d_ws;
    (void)hipMemsetAsync((unsigned char*)d_ws + WS_BAR, 0, 16384, stream);
    void* args[] = {&p};
    hipError_t e = hipLaunchCooperativeKernel((const void*)mega_fwd, dim3(grid_blocks), dim3(NTHR), args, LDS_BYTES, stream);
    if (e != hipSuccess) fprintf(stderr, "kernel_launch: cooperative launch failed: %s (grid %d)\n", hipGetErrorString(e), grid_blocks);
}
```

```cpp
#include <hip/hip_runtime.h>
#include <hip/hip_cooperative_groups.h>
#include <cstdio>
namespace cg = cooperative_groups;

#define DI __device__ __forceinline__
#define LAS __attribute__((address_space(3)))
typedef short s16x4 __attribute__((ext_vector_type(4)));
typedef float f32x16 __attribute__((ext_vector_type(16)));
typedef __bf16 bf16v2 __attribute__((ext_vector_type(2)));
typedef float f32v2 __attribute__((ext_vector_type(2)));

namespace pg8 {
#define PG8_LAS __attribute__((address_space(3)))
typedef unsigned short bf16_t;
typedef short bf16x8 __attribute__((ext_vector_type(8)));
typedef float f32x4 __attribute__((ext_vector_type(4)));
typedef unsigned u32x4 __attribute__((ext_vector_type(4)));
constexpr int BM = 256, BK = 64, HALF = 128, HTB = HALF * BK * 2  , STAGE_BYTES = 8 * HTB, NXCD = 8, WGM = 8;

__host__ __device__ __forceinline__ int lds_byte(int r, int c) { const int st = (r >> 4) * 2 + (c >> 5), rr = r & 15, cc = c & 31, ob = rr * 64 + cc * 2; return st * 1024 + (ob ^ (((ob >> 9) & 1) << 5)); }
__host__ __device__ __forceinline__ void stage_rc(int b, int& R, int& C) { const int st = b / 1024, sb = b % 1024, swz = sb ^ (((sb >> 9) & 1) << 5); R = (st >> 1) * 16 + swz / 64; C = (st & 1) * 32 + (swz % 64) / 2; }
__host__ __device__ __forceinline__ int perm32(int rho) { const int n = rho >> 4, i = rho & 15; return 8 * (i >> 2) + 4 * n + (i & 3); }

struct Unit { int pm, pn; };
struct Gemm { const bf16_t* A; const bf16_t* Bt; int M, N, K; };
struct StaticOrder {
    int nM, nN, nwg, G, c;
    __host__ __device__ void init(int M, int N, int G_, int c_) { nM = M / BM; nN = N / BM; nwg = nM * nN; G = G_; c = c_; }
    __host__ __device__ bool next(int i, Unit& u) const {
        const long L = (long)i * G + c; if (L >= nwg) return false;
        int wgid = (int)L; { const int q = nwg / NXCD, r = nwg % NXCD, xcd = wgid % NXCD, off = wgid / NXCD; wgid = (xcd < r ? xcd * (q + 1) : r * (q + 1) + (xcd - r) * q) + off; }
        const int nig = WGM * nN, gid = wgid / nig, fm = gid * WGM, gsz = (nM - fm) < WGM ? (nM - fm) : WGM;
        u.pm = fm + ((wgid % nig) % gsz); u.pn = (wgid % nig) / gsz; return true;
    }
    __device__ __forceinline__ void a_ready(const Unit&) const {}
    __device__ __forceinline__ void done(const Unit&) const {}
};
__device__ __forceinline__ unsigned cvt_pk_bf16(float lo, float hi) { unsigned r; asm volatile("v_cvt_pk_bf16_f32 %0, %1, %2" : "=v"(r) : "v"(lo), "v"(hi)); return r; }
template <class Epi, class Sched>
__device__ __forceinline__ void gemm_phase(PG8_LAS unsigned char* lds, const Gemm g, const Sched& S, const Epi& E) {
    int tid_o = __builtin_amdgcn_readfirstlane((int)threadIdx.x >> 6) * 64 + (int)__builtin_amdgcn_mbcnt_hi(~0u, __builtin_amdgcn_mbcnt_lo(~0u, 0u)); asm volatile("" : "+v"(tid_o));
    const int tid = tid_o, wid = __builtin_amdgcn_readfirstlane(tid >> 6), lane = tid & 63, wr = wid >> 2, wc = wid & 3, fr = lane & 15, fq = lane >> 4;
    const int K = g.K, nt = K / BK;
    unsigned voffA[2], voffB[2];
#pragma unroll
    for (int i = 0; i < 2; ++i) { int R, C; stage_rc(tid * 16 + i * 8192, R, C); const int Rb = Epi::PERM ? ((R & ~31) + perm32(R & 31)) : R;
        voffA[i] = (unsigned)(R * K + C) * 2u; voffB[i] = (unsigned)(Rb * K + C) * 2u; }
    const size_t kstep = (size_t)(BK * 2);
    const size_t hstep = (size_t)HALF * K * 2;
    const size_t tstep = 2 * hstep;
    const unsigned ldsw = (unsigned)wid * 1024u;
    const int aoff = lds_byte(wr * 64 + fr, fq * 8), boff = lds_byte(wc * 32 + fr, fq * 8);
#define PG8_SA(b, h) (((b) * 2 + (h)) * HTB)
#define PG8_SB(b, h) ((4 + (b) * 2 + (h)) * HTB)
#define PG8_STAGE(bufoff, gbase, voff) do { _Pragma("unroll") for (int _i = 0; _i < 2; ++_i) \
        __builtin_amdgcn_global_load_lds((const unsigned*)((const char*)(gbase) + (voff)[_i]), (PG8_LAS unsigned*)(lds + (bufoff) + ldsw + _i * 8192), 16, 0, 0); } while (0)
#define PG8_LDA(dst, b, h) do { _Pragma("unroll") for (int m = 0; m < 4; ++m) _Pragma("unroll") for (int k = 0; k < 2; ++k) dst[m][k] = *(const PG8_LAS bf16x8*)(lds + PG8_SA(b, h) + aoff + m * 2048 + k * 1024); } while (0)
#define PG8_LDB(dst, b, h) do { _Pragma("unroll") for (int n = 0; n < 2; ++n) _Pragma("unroll") for (int k = 0; k < 2; ++k) dst[n][k] = *(const PG8_LAS bf16x8*)(lds + PG8_SB(b, h) + boff + n * 2048 + k * 1024); } while (0)
#define PG8_MMA(ai, bj, At, Bt) do { __builtin_amdgcn_s_setprio(1); _Pragma("unroll") for (int m = 0; m < 4; ++m) _Pragma("unroll") for (int n = 0; n < 2; ++n) _Pragma("unroll") for (int k = 0; k < 2; ++k) \
        acc[ai][bj][m][n] = __builtin_amdgcn_mfma_f32_16x16x32_bf16(Bt[n][k], At[m][k], acc[ai][bj][m][n], 0, 0, 0); __builtin_amdgcn_s_setprio(0); } while (0)
#define PG8_WAIT_V(n) asm volatile("s_waitcnt vmcnt(" #n ")" ::: "memory")
#define PG8_WAIT_L(n) asm volatile("s_waitcnt lgkmcnt(" #n ")" ::: "memory")
#define PG8_BAR __builtin_amdgcn_s_barrier()
#define PG8_SCHED __builtin_amdgcn_sched_barrier(0)
    Unit cur, nxt; int ui = 0;
    if (!S.next(0, cur)) return;
    f32x4 acc[2][2][4][2];
#pragma unroll
    for (int a = 0; a < 2; ++a)
#pragma unroll
        for (int b = 0; b < 2; ++b)
#pragma unroll
            for (int m = 0; m < 4; ++m)
#pragma unroll
                for (int n = 0; n < 2; ++n) acc[a][b][m][n] = (f32x4){0.f, 0.f, 0.f, 0.f};
    bf16x8 At[4][2], B0[2][2], B1[2][2];
    const char* cA = (const char*)g.A + (size_t)cur.pm * tstep; const char* cB = (const char*)g.Bt + (size_t)cur.pn * tstep;
    S.a_ready(cur);
    PG8_STAGE(PG8_SB(0, 0), cB, voffB); PG8_STAGE(PG8_SB(0, 1), cB + hstep, voffB); PG8_STAGE(PG8_SA(0, 0), cA, voffA); PG8_STAGE(PG8_SA(0, 1), cA + hstep, voffA);
    if (wr == 1) PG8_BAR;
    PG8_WAIT_V(2); PG8_BAR;
    PG8_STAGE(PG8_SB(1, 0), cB + kstep, voffB); PG8_STAGE(PG8_SA(1, 0), cA + kstep, voffA); PG8_STAGE(PG8_SB(1, 1), cB + hstep + kstep, voffB);
    PG8_WAIT_V(6); PG8_BAR;
    for (;;) {
        const bool has_next = S.next(ui + 1, nxt);
        const char* nA = has_next ? (const char*)g.A + (size_t)nxt.pm * tstep : cA; const char* nB = has_next ? (const char*)g.Bt + (size_t)nxt.pn * tstep : cB;
        for (int t = 0; t < nt; t += 2) {
            const bool last = (t == nt - 2);
            const char* a1 = cA + (size_t)(t + 1) * kstep;
            const char* a2 = last ? nA : cA + (size_t)(t + 2) * kstep; const char* b2 = last ? nB : cB + (size_t)(t + 2) * kstep;
            const char* a3 = a2 + kstep; const char* b3 = b2 + kstep;
            if (last && has_next) S.a_ready(nxt);
            PG8_LDB(B0, 0, 0); PG8_LDB(B1, 0, 1); PG8_SCHED; PG8_LDA(At, 0, 0); PG8_STAGE(PG8_SA(1, 1), a1 + hstep, voffA);
            PG8_WAIT_V(8); PG8_WAIT_L(0); PG8_BAR; PG8_MMA(0, 0, At, B0); PG8_MMA(0, 1, At, B1); PG8_BAR; PG8_SCHED;
            PG8_LDA(At, 0, 1); PG8_STAGE(PG8_SB(0, 0), b2, voffB); PG8_STAGE(PG8_SB(0, 1), b2 + hstep, voffB); PG8_STAGE(PG8_SA(0, 0), a2, voffA);
            PG8_WAIT_V(8); PG8_WAIT_L(0); PG8_BAR; PG8_MMA(1, 0, At, B0); PG8_MMA(1, 1, At, B1); PG8_BAR; PG8_SCHED;
            PG8_LDB(B0, 1, 0); PG8_LDB(B1, 1, 1); PG8_SCHED; PG8_LDA(At, 1, 0); PG8_STAGE(PG8_SA(0, 1), a2 + hstep, voffA);
            PG8_WAIT_V(8); PG8_WAIT_L(0); PG8_BAR; PG8_MMA(0, 0, At, B0); PG8_MMA(0, 1, At, B1); PG8_BAR; PG8_SCHED;
            PG8_LDA(At, 1, 1); PG8_STAGE(PG8_SB(1, 0), b3, voffB); PG8_STAGE(PG8_SB(1, 1), b3 + hstep, voffB); PG8_STAGE(PG8_SA(1, 0), a3, voffA);
            PG8_WAIT_V(8); PG8_WAIT_L(0); PG8_BAR; PG8_MMA(1, 0, At, B0); PG8_MMA(1, 1, At, B1); PG8_BAR; PG8_SCHED;
        }
        if (wr == 0) PG8_BAR;
        if constexpr (!Epi::AFTER_DRAIN) { E(acc, cur, wr, wc, fr, fq, ui); S.done(cur); }
        if (!has_next) break;
#pragma unroll
        for (int a = 0; a < 2; ++a)
#pragma unroll
            for (int b = 0; b < 2; ++b)
#pragma unroll
                for (int m = 0; m < 4; ++m)
#pragma unroll
                    for (int n = 0; n < 2; ++n) acc[a][b][m][n] = (f32x4){0.f, 0.f, 0.f, 0.f};
        cur = nxt; cA = nA; cB = nB; ++ui;
        if (wr == 1) PG8_BAR;
    }
    PG8_WAIT_V(0);
    PG8_BAR;
    if constexpr (Epi::AFTER_DRAIN) { E.fused(acc, cur, wr, wc, fr, fq, lds, wid, lane); S.done(cur); }
#undef PG8_SA
#undef PG8_SB
#undef PG8_STAGE
#undef PG8_LDA
#undef PG8_LDB
#undef PG8_MMA
#undef PG8_WAIT_V
#undef PG8_WAIT_L
#undef PG8_BAR
#undef PG8_SCHED
}
}

using pg8::bf16_t; using pg8::bf16x8; using pg8::f32x4; using pg8::u32x4;
typedef unsigned u32x2 __attribute__((ext_vector_type(2)));

constexpr int D = 1024, SEQ = 4096, GSEQ = 8, TG = GSEQ * SEQ  , NGRP = 3  ;
constexpr int EIN = 3072, RIN = 6144, F2 = 5632, FF = 2816, RMIX = 2048;
constexpr float LOG2E = 1.4426950408889634f;
constexpr int NTHR = 512;
constexpr int LDS_BYTES = 160 * 1024;

constexpr size_t WS_WIN0 = 0;
constexpr size_t WS_WOUT0 = WS_WIN0 + (size_t)EIN * D * 2;
constexpr size_t WS_WRIN = WS_WOUT0 + (size_t)D * D * 2;
constexpr size_t WS_WROUT = WS_WRIN + (size_t)RIN * D * 2;
constexpr size_t WS_WUP = WS_WROUT + (size_t)D * RMIX * 2;
constexpr size_t WS_WDN = WS_WUP + 2 * (size_t)F2 * D * 2;
constexpr size_t WS_ROPE64 = WS_WDN + 2 * (size_t)D * FF * 2;
constexpr size_t WS_ROPE256 = WS_ROPE64 + (size_t)SEQ * 32 * 8;
constexpr size_t WS_H = WS_ROPE256 + (size_t)SEQ * 128 * 8;
constexpr size_t WS_R = WS_H + (size_t)TG * D * 2;
constexpr size_t WS_P = WS_R + 2 * (size_t)TG * RMIX * 2;
constexpr size_t WS_O = WS_P + (size_t)TG * RIN * 2;
constexpr size_t WS_BAR = WS_O + (size_t)TG * FF * 2;
constexpr size_t WS_SS = WS_BAR + 16384;
constexpr size_t WS_LG2 = WS_SS + 4 * (size_t)TG * 64;
constexpr size_t WS_EDGE = WS_LG2 + 256;
constexpr size_t WS_END = WS_EDGE + (size_t)(TG / 64) * 4 * F2 * 2;

struct Params {
    const float* xp; const float* xs; const float* attn_norm; const float* even_w_in; const float* na_rpb; const float* even_w_out;
    const float* ret_w_in; const float* dec_f; const float* dec_b; const float* ret_w_out; const float* ffn_norm; const float* ffn_w_up;
    const float* conv_w; const float* conv_b; const float* ffn_w_down; const float* final_norm;
    float* out; unsigned char* ws;
};

DI unsigned pack_bf16(float lo, float hi) { f32v2 f = {lo, hi}; bf16v2 b = __builtin_convertvector(f, bf16v2); return __builtin_bit_cast(unsigned, b); }
DI float bf_lo(unsigned u) { return __uint_as_float(u << 16); }
DI float bf_hi(unsigned u) { return __uint_as_float(u & 0xffff0000u); }
DI int raw_tid() { return __builtin_amdgcn_readfirstlane((int)threadIdx.x >> 6) * 64 + (int)__builtin_amdgcn_mbcnt_hi(~0u, __builtin_amdgcn_mbcnt_lo(~0u, 0u)); }
DI int otid() { int t = raw_tid(); asm volatile("" : "+v"(t)); return t; }
DI int vblock() { const int G = gridDim.x, bx = blockIdx.x; return (G & 7) == 0 ? (bx & 7) * (G >> 3) + (bx >> 3) : bx; }
DI float fexp2(float x) { return __builtin_amdgcn_exp2f(x); }
DI float shx(float v, int o) { int l = (int)__builtin_amdgcn_mbcnt_hi(~0u, __builtin_amdgcn_mbcnt_lo(~0u, 0u)); asm volatile("" : "+v"(l)); return __int_as_float(__builtin_amdgcn_ds_bpermute((l ^ o) << 2, __float_as_int(v))); }
DI float wave_sum(float v) {
#pragma unroll
    for (int o = 32; o >= 1; o >>= 1) v += shx(v, o);
    return v;
}
DI bf16x8 lds_r128(LAS unsigned char* L, int off) { return *(LAS bf16x8*)(L + off); }
DI void lds_w128(LAS unsigned char* L, int off, bf16x8 v) { *(LAS bf16x8*)(L + off) = v; }
DI s16x4 lds_tr(LAS unsigned char* L, int off) { return __builtin_amdgcn_ds_read_tr16_b64_v4i16((LAS s16x4*)(L + off)); }
DI bf16x8 cat4(s16x4 lo, s16x4 hi) { return __builtin_shufflevector(lo, hi, 0, 1, 2, 3, 4, 5, 6, 7); }
DI f32x16 mfma32(bf16x8 a, bf16x8 b, f32x16 c) { return __builtin_amdgcn_mfma_f32_32x32x16_bf16(a, b, c, 0, 0, 0); }
DI f32x4 mfma16(bf16x8 a, bf16x8 b, f32x4 c) { return __builtin_amdgcn_mfma_f32_16x16x32_bf16(a, b, c, 0, 0, 0); }
DI void unpack8(const u32x4 a, float* f) {
#pragma unroll
    for (int j = 0; j < 4; ++j) { f[2 * j] = bf_lo(a[j]); f[2 * j + 1] = bf_hi(a[j]); }
}
DI bf16x8 pack8(const float* v) { u32x4 w; w.x = pack_bf16(v[0], v[1]); w.y = pack_bf16(v[2], v[3]); w.z = pack_bf16(v[4], v[5]); w.w = pack_bf16(v[6], v[7]); return __builtin_bit_cast(bf16x8, w); }

constexpr int RS_LDS_OFF = 131072, RS_MAX_UNITS = 30;
static_assert(RS_LDS_OFF + RS_MAX_UNITS * 1024 <= LDS_BYTES - 16, "row-scale table");
struct EpiBf16 {
    static constexpr bool PERM = true, AFTER_DRAIN = false, NEEDS_RS = true;
    bf16_t* O; int ldc; const float* ss; LAS unsigned char* L; const float2* rtab; int rpn0, rpn1, rhd;
    DI void operator()(const f32x4 (&acc)[2][2][4][2], const pg8::Unit& u, int wr, int wc, int fr, int fq, int ui) const {
        const int row0 = u.pm * 256 + wr * 64 + fr, col0 = u.pn * 256 + wc * 32 + 8 * fq;
        const LAS float* tab = (const LAS float*)(L + RS_LDS_OFF) + ui * 256 + wr * 64 + fr;
        float rs[2][4];
#pragma unroll
        for (int ai = 0; ai < 2; ++ai)
#pragma unroll
            for (int m = 0; m < 4; ++m) rs[ai][m] = tab[ai * 128 + m * 16];
        const bool rot = (u.pn >= rpn0) && (u.pn < rpn1);
        if (!rot) {
#pragma unroll
            for (int ai = 0; ai < 2; ++ai)
#pragma unroll
                for (int m = 0; m < 4; ++m) { bf16_t* rowp = O + (size_t)(row0 + ai * 128 + m * 16) * ldc + col0;
                    const float sc = rs[ai][m];
#pragma unroll
                    for (int bj = 0; bj < 2; ++bj) { const f32x4 v0 = acc[ai][bj][m][0] * sc, v1 = acc[ai][bj][m][1] * sc;
                        u32x4 w; w.x = pack_bf16(v0[0], v0[1]); w.y = pack_bf16(v0[2], v0[3]); w.z = pack_bf16(v1[0], v1[1]); w.w = pack_bf16(v1[2], v1[3]);
                        *(u32x4*)(rowp + bj * 128) = w; } }
        } else {
            const int hpairs = rhd >> 1;
#pragma unroll
            for (int ai = 0; ai < 2; ++ai)
#pragma unroll
                for (int bj = 0; bj < 2; ++bj) {
                    const int i0 = ((col0 + bj * 128) & (rhd - 1)) >> 1;
                    f32x4 cs[4][2];
#pragma unroll
                    for (int m = 0; m < 4; ++m) { const int pos = (row0 + ai * 128 + m * 16) & (SEQ - 1); const f32x4* tp = (const f32x4*)(rtab + (size_t)pos * hpairs + i0); cs[m][0] = tp[0]; cs[m][1] = tp[1]; }
#pragma unroll
                    for (int m = 0; m < 4; ++m) {
                        const float sc = rs[ai][m];
                        const f32x4 v0 = acc[ai][bj][m][0] * sc, v1 = acc[ai][bj][m][1] * sc;
                        const f32x4 c0 = cs[m][0], c1 = cs[m][1];
                        u32x4 w;
                        w.x = pack_bf16(v0[0] * c0[0] - v0[1] * c0[1], v0[0] * c0[1] + v0[1] * c0[0]);
                        w.y = pack_bf16(v0[2] * c0[2] - v0[3] * c0[3], v0[2] * c0[3] + v0[3] * c0[2]);
                        w.z = pack_bf16(v1[0] * c1[0] - v1[1] * c1[1], v1[0] * c1[1] + v1[1] * c1[0]);
                        w.w = pack_bf16(v1[2] * c1[2] - v1[3] * c1[3], v1[2] * c1[3] + v1[3] * c1[2]);
                        *(u32x4*)(O + (size_t)(row0 + ai * 128 + m * 16) * ldc + col0 + bj * 128) = w;
                    }
                }
        }
    }
};
template <bool LAST> struct EpiRes {
    static constexpr bool PERM = true, AFTER_DRAIN = false, NEEDS_RS = false;
    bf16_t* hb; float* out; float* ss; bf16_t* ho;
    DI void operator()(const f32x4 (&acc)[2][2][4][2], const pg8::Unit& u, int wr, int wc, int fr, int fq, int) const {
        const int row0 = u.pm * 256 + wr * 64 + fr, col0 = u.pn * 256 + wc * 32 + 8 * fq;
#pragma unroll
        for (int ai = 0; ai < 2; ++ai) {
            u32x4 r[4][2];
#pragma unroll
            for (int m = 0; m < 4; ++m) { const size_t ro = (size_t)(row0 + ai * 128 + m * 16) * D + col0;
#pragma unroll
                for (int bj = 0; bj < 2; ++bj) r[m][bj] = *(const u32x4*)(hb + ro + bj * 128); }
            asm volatile("" ::: "memory");
#pragma unroll
            for (int m = 0; m < 4; ++m) { const size_t ro = (size_t)(row0 + ai * 128 + m * 16) * D + col0;
                float sq = 0.f;
#pragma unroll
                for (int bj = 0; bj < 2; ++bj) {
                    const u32x4 rr = r[m][bj];
                    const f32x4 v0 = (f32x4){bf_lo(rr[0]), bf_hi(rr[0]), bf_lo(rr[1]), bf_hi(rr[1])} + acc[ai][bj][m][0];
                    const f32x4 v1 = (f32x4){bf_lo(rr[2]), bf_hi(rr[2]), bf_lo(rr[3]), bf_hi(rr[3])} + acc[ai][bj][m][1];
                    if (LAST) { *(f32x4*)(out + ro + bj * 128) = v0; *(f32x4*)(out + ro + bj * 128 + 4) = v1; }
                    else {
                        u32x4 w; w.x = pack_bf16(v0[0], v0[1]); w.y = pack_bf16(v0[2], v0[3]); w.z = pack_bf16(v1[0], v1[1]); w.w = pack_bf16(v1[2], v1[3]);
                        *(u32x4*)(ho + ro + bj * 128) = w;
                        sq += v0[0] * v0[0] + v0[1] * v0[1] + v0[2] * v0[2] + v0[3] * v0[3] + v1[0] * v1[0] + v1[1] * v1[1] + v1[2] * v1[2] + v1[3] * v1[3];
                    }
                }
                if (!LAST) {
                    sq += shx(sq, 16); sq += shx(sq, 32);
                    if (fq == 0) ss[(size_t)(row0 + ai * 128 + m * 16) * 16 + u.pn * 4 + wc] = sq;
                }
            }
        }
    }
};
DI float gelu_tanh(float x) { const float t = x * (1.5957691216057308f + 0.0713548162726009f * x * x); return x * __builtin_amdgcn_rcpf(1.0f + fexp2(-LOG2E * t)); }
DI float rotr1(float v) { return __int_as_float(__builtin_amdgcn_mov_dpp(__float_as_int(v), 0x121, 0xf, 0xf, false)); }
DI float rotl1(float v) { return __int_as_float(__builtin_amdgcn_mov_dpp(__float_as_int(v), 0x12f, 0xf, 0xf, false)); }
struct EpiConv {
    static constexpr bool PERM = true, AFTER_DRAIN = false, NEEDS_RS = true;
    bf16_t* O; const float* ss; LAS unsigned char* L; const float* cw; const float* cb; bf16_t* edge;
    DI void operator()(const f32x4 (&acc)[2][2][4][2], const pg8::Unit& u, int wr, int wc, int fr, int fq, int ui) const {
        const LAS float* tab = (const LAS float*)(L + RS_LDS_OFF) + ui * 256 + wr * 64 + fr;
        f32x4 wuA[2][3], wgA[2][3], buA[2], bgA[2];
#pragma unroll
        for (int n = 0; n < 2; ++n) {
            const int f0 = u.pn * 128 + wc * 32 + 8 * fq + 4 * n;
#pragma unroll
            for (int j = 0; j < 3; ++j) { wuA[n][j] = *(const f32x4*)(cw + (size_t)j * F2 + f0); wgA[n][j] = *(const f32x4*)(cw + (size_t)j * F2 + FF + f0); }
            buA[n] = *(const f32x4*)(cb + f0); bgA[n] = *(const f32x4*)(cb + FF + f0);
        }
#pragma unroll
        for (int n = 0; n < 2; ++n) {
            const int f0 = u.pn * 128 + wc * 32 + 8 * fq + 4 * n;
            f32x4 wu[3], wg[3];
#pragma unroll
            for (int j = 0; j < 3; ++j) { wu[j] = wuA[n][j]; wg[j] = wgA[n][j]; }
            const f32x4 bu = buA[n], bg = bgA[n];
#pragma unroll
            for (int ai = 0; ai < 2; ++ai) {
                const int rowb = u.pm * 256 + ai * 128 + wr * 64;
                f32x4 U[4], G[4];
#pragma unroll
                for (int m = 0; m < 4; ++m) { const float s_ = tab[ai * 128 + m * 16]; U[m] = acc[ai][0][m][n] * s_; G[m] = acc[ai][1][m][n] * s_; }
                if (fr < 2) { bf16_t* ep = edge + ((size_t)(rowb >> 6) * 4 + fr) * F2 + u.pn * 256 + wc * 32 + 8 * fq + 4 * n;
                    u32x2 a; a.x = pack_bf16(U[0][0], U[0][1]); a.y = pack_bf16(U[0][2], U[0][3]); *(u32x2*)ep = a;
                    u32x2 c; c.x = pack_bf16(G[0][0], G[0][1]); c.y = pack_bf16(G[0][2], G[0][3]); *(u32x2*)(ep + 128) = c; }
                if (fr >= 14) { bf16_t* ep = edge + ((size_t)(rowb >> 6) * 4 + (fr - 12)) * F2 + u.pn * 256 + wc * 32 + 8 * fq + 4 * n;
                    u32x2 a; a.x = pack_bf16(U[3][0], U[3][1]); a.y = pack_bf16(U[3][2], U[3][3]); *(u32x2*)ep = a;
                    u32x2 c; c.x = pack_bf16(G[3][0], G[3][1]); c.y = pack_bf16(G[3][2], G[3][3]); *(u32x2*)(ep + 128) = c; }
#pragma unroll
                for (int m = 0; m < 4; ++m) {
                    float o[4];
#pragma unroll
                    for (int e = 0; e < 4; ++e) {
                        const float pu_s = rotr1(U[m][e]), pg_s = rotr1(G[m][e]), nu_s = rotl1(U[m][e]), ng_s = rotl1(G[m][e]);
                        const float pu_x = rotr1(U[m > 0 ? m - 1 : 0][e]), pg_x = rotr1(G[m > 0 ? m - 1 : 0][e]);
                        const float nu_x = rotl1(U[m < 3 ? m + 1 : 3][e]), ng_x = rotl1(G[m < 3 ? m + 1 : 3][e]);
                        const float pu = fr == 0 ? pu_x : pu_s, pg = fr == 0 ? pg_x : pg_s, nu = fr == 15 ? nu_x : nu_s, ng = fr == 15 ? ng_x : ng_s;
                        const float yu = bu[e] + pu * wu[0][e] + U[m][e] * wu[1][e] + nu * wu[2][e];
                        const float yg = bg[e] + pg * wg[0][e] + G[m][e] * wg[1][e] + ng * wg[2][e];
                        o[e] = yu * gelu_tanh(yg);
                    }
                    const bool edge_row = (m == 0 && fr == 0) || (m == 3 && fr == 15);
                    if (!edge_row) { u32x2 w; w.x = pack_bf16(o[0], o[1]); w.y = pack_bf16(o[2], o[3]); *(u32x2*)(O + (size_t)(rowb + m * 16 + fr) * FF + f0) = w; }
                }
            }
        }
    }
};
DI void ffn_fix_phase(const bf16_t* __restrict__ edge, bf16_t* __restrict__ Oo, const float* __restrict__ cw, const float* __restrict__ cb, int T) {
    constexpr int NCH = FF / 8;
    const int total = (T / 64) * 2 * NCH;
    for (int it = blockIdx.x * NTHR + otid(); it < total; it += gridDim.x * NTHR) {
        const int fc = it % NCH, rs = it / NCH, side = rs & 1, blk = rs >> 1, f0 = fc * 8;
        const int t = blk * 64 + (side ? 63 : 0), ts = t & (SEQ - 1);
        const int cu = 256 * (f0 >> 7) + (f0 & 127);
        const bf16_t* eb = edge + (size_t)blk * 4 * F2 + cu;
        const bf16_t* pp = side ? eb + 2 * F2 : eb - F2;
        const bf16_t* cp = side ? eb + 3 * F2 : eb;
        const bf16_t* np = side ? eb + 4 * F2 : eb + F2;
        const bool pz = (side == 0 && ts == 0), nz = (side == 1 && ts == SEQ - 1);
        float pu[8], pg[8], cu_[8], cg_[8], nu[8], ng[8];
        if (pz) {
#pragma unroll
            for (int e = 0; e < 8; ++e) { pu[e] = 0.f; pg[e] = 0.f; }
        } else { unpack8(*(const u32x4*)pp, pu); unpack8(*(const u32x4*)(pp + 128), pg); }
        unpack8(*(const u32x4*)cp, cu_); unpack8(*(const u32x4*)(cp + 128), cg_);
        if (nz) {
#pragma unroll
            for (int e = 0; e < 8; ++e) { nu[e] = 0.f; ng[e] = 0.f; }
        } else { unpack8(*(const u32x4*)np, nu); unpack8(*(const u32x4*)(np + 128), ng); }
        float o[8];
#pragma unroll
        for (int e = 0; e < 8; ++e) {
            const float yu = cb[f0 + e] + pu[e] * cw[f0 + e] + cu_[e] * cw[F2 + f0 + e] + nu[e] * cw[2 * F2 + f0 + e];
            const float yg = cb[FF + f0 + e] + pg[e] * cw[FF + f0 + e] + cg_[e] * cw[F2 + FF + f0 + e] + ng[e] * cw[2 * F2 + FF + f0 + e];
            o[e] = yu * gelu_tanh(yg);
        }
        *(bf16x8*)(Oo + (size_t)t * FF + f0) = pack8(o);
    }
}
template <class Epi> DI void run_gemm(LAS unsigned char* L, const bf16_t* A, const bf16_t* Bt, int M, int N, int K, const Epi& E) {
    pg8::Gemm g{A, Bt, M, N, K}; pg8::StaticOrder S; S.init(M, N, (int)gridDim.x, (int)blockIdx.x);
    if constexpr (Epi::NEEDS_RS) {
        const int tid = otid(), row = tid >> 1, hf = tid & 1;
        LAS float* tab = (LAS float*)(L + RS_LDS_OFF);
        pg8::Unit u;
        int nun = 0;
        while (nun < RS_MAX_UNITS && S.next(nun, u)) ++nun;
        for (int i0 = 0; i0 < nun; i0 += 4) {
            f32x4 a[4], c[4];
#pragma unroll
            for (int k = 0; k < 4; ++k) { const int i = i0 + k < nun ? i0 + k : nun - 1; S.next(i, u);
                const float* sp = E.ss + (size_t)(u.pm * 256 + row) * 16 + 8 * hf; a[k] = *(const f32x4*)sp; c[k] = *(const f32x4*)(sp + 4); }
#pragma unroll
            for (int k = 0; k < 4; ++k) {
                float s = ((a[k][0] + a[k][1]) + (a[k][2] + a[k][3])) + ((c[k][0] + c[k][1]) + (c[k][2] + c[k][3]));
                s += shx(s, 1);
                if (hf == 0 && i0 + k < nun) tab[(i0 + k) * 256 + row] = rsqrtf(s * (1.0f / D) + 1e-6f);
            }
        }
        __syncthreads();
    }
    pg8::gemm_phase<Epi, pg8::StaticOrder>(L, g, S, E);
}

DI void prep_matrix(LAS unsigned char* L, const float* W, int Kd, int Nd, const float* gain, bf16_t* WT, int sa0, int sa1, int sb0, int sb1, float cscale, int& boff, bool ffn_perm = false, int rot0 = 0, int rot1 = 0, int rhd = 64) {
    LAS float* tile = (LAS float*)L;
    const int tid = otid(), tn = Nd / 256, nt = (Kd / 64) * tn, G = (int)gridDim.x;
    const int first = ((int)blockIdx.x + G - (boff % G)) % G;
    boff += nt;
    f32x4 v[8];
    if (first < nt) { const int k0 = (first / tn) * 64, n0 = (first % tn) * 256;
#pragma unroll
        for (int i = 0; i < 8; ++i) { const int idx = tid + NTHR * i, k = idx >> 6, c4 = idx & 63; v[i] = *(const f32x4*)(W + (size_t)(k0 + k) * Nd + n0 + 4 * c4); } }
    for (int t = first; t < nt; t += G) {
        const int k0 = (t / tn) * 64, n0 = (t % tn) * 256;
        __syncthreads();
#pragma unroll
        for (int i = 0; i < 8; ++i) {
            const int idx = tid + NTHR * i, k = idx >> 6, c4 = idx & 63;
            const float gk = gain ? gain[k0 + k] : 1.0f;
#pragma unroll
            for (int q = 0; q < 4; ++q) {
                const int col = n0 + 4 * c4 + q;
                float x = v[i][q] * gk;
                if ((col >= sa0 && col < sa1) || (col >= sb0 && col < sb1)) x *= cscale;
                tile[k * 257 + 4 * c4 + q] = x;
            }
        }
        { const int tnx = t + G < nt ? t + G : t, k1 = (tnx / tn) * 64, n1 = (tnx % tn) * 256;
#pragma unroll
          for (int i = 0; i < 8; ++i) { const int idx = tid + NTHR * i, k = idx >> 6, c4 = idx & 63; v[i] = *(const f32x4*)(W + (size_t)(k1 + k) * Nd + n1 + 4 * c4); } }
        __syncthreads();
#pragma unroll
        for (int j = 0; j < 4; ++j) {
            const int item = tid + NTHR * j, n = item >> 3, ch = item & 7;
            u32x4 w;
            w.x = pack_bf16(tile[(ch * 8 + 0) * 257 + n], tile[(ch * 8 + 1) * 257 + n]);
            w.y = pack_bf16(tile[(ch * 8 + 2) * 257 + n], tile[(ch * 8 + 3) * 257 + n]);
            w.z = pack_bf16(tile[(ch * 8 + 4) * 257 + n], tile[(ch * 8 + 5) * 257 + n]);
            w.w = pack_bf16(tile[(ch * 8 + 6) * 257 + n], tile[(ch * 8 + 7) * 257 + n]);
            int orow = n0 + n;
            if (orow >= rot0 && orow < rot1) { const int c = orow - rot0, d = c % rhd, hf = rhd >> 1; orow = rot0 + (c - d) + (d < hf ? 2 * d : 2 * (d - hf) + 1); }
            if (ffn_perm) { const int gate = orow >= FF, f = gate ? orow - FF : orow; orow = 256 * (f >> 7) + 128 * gate + (f & 127); }
            *(u32x4*)(WT + (size_t)orow * Kd + k0 + ch * 8) = w;
        }
    }
    __syncthreads();
}
DI void sincos_d(double a, float& c, float& s) {
    const double TWO_PI = 6.283185307179586476925286766559;
    const double k = __builtin_rint(a / TWO_PI);
    const double r = __builtin_fma(-k, TWO_PI, a);
    const double x = r * r;
    const double SC[14] = {1.0, -0.16666666666666666, 0.008333333333333333, -0.0001984126984126984, 2.7557319223985893e-06, -2.505210838544172e-08, 1.6059043836821613e-10, -7.647163731819816e-13, 2.8114572543455206e-15, -8.22063524662433e-18, 1.9572941063391263e-20, -3.868170170630684e-23, 6.446950284384474e-26, -9.183689863795546e-29};
    const double CC[14] = {1.0, -0.5, 0.041666666666666664, -0.001388888888888889, 2.48015873015873e-05, -2.755731922398589e-07, 2.08767569878681e-09, -1.1470745597729725e-11, 4.779477332387385e-14, -1.5619206968586225e-16, 4.110317623312165e-19, -8.896791392450574e-22, 1.6117375710961184e-24, -2.4795962632247976e-27};
    double ps = SC[13], pc = CC[13];
#pragma unroll
    for (int n = 12; n >= 0; --n) { ps = __builtin_fma(ps, x, SC[n]); pc = __builtin_fma(pc, x, CC[n]); }
    c = (float)pc; s = (float)(ps * r);
}
DI void rope_tables(float2* r64, float2* r256) {
    const int gt = blockIdx.x * NTHR + otid(), nth = gridDim.x * NTHR;
    const double LN_THETA = 9.210340371976184;
    for (int idx = gt; idx < SEQ * 32; idx += nth) { const int pos = idx >> 5, i = idx & 31; const double inv = exp(-(double)i / 32.0 * LN_THETA); float c, s; sincos_d((double)pos * inv, c, s); r64[idx] = make_float2(c, s); }
    for (int idx = gt; idx < SEQ * 128; idx += nth) { const int pos = idx >> 7, i = idx & 127; const double inv = exp(-(double)i / 128.0 * LN_THETA); float c, s; sincos_d((double)pos * inv, c, s); r256[idx] = make_float2(c, s); }
}

DI void cvt_phase(const float* __restrict__ x, bf16_t* __restrict__ h, float* __restrict__ ss, int rows) {
    const int tid = otid(), wave = tid >> 6, lane = tid & 63;
    constexpr int RB = 4;
    for (int row0 = (blockIdx.x * 8 + wave) * RB; row0 < rows; row0 += gridDim.x * 8 * RB) {
        float4 v[RB][4];
#pragma unroll
        for (int r = 0; r < RB; ++r)
#pragma unroll
            for (int i = 0; i < 4; ++i) v[r][i] = ((const float4*)(x + (size_t)(row0 + r) * D))[i * 64 + lane];
#pragma unroll
        for (int r = 0; r < RB; ++r) {
            float s2 = 0.f;
#pragma unroll
            for (int i = 0; i < 4; ++i) s2 += v[r][i].x * v[r][i].x + v[r][i].y * v[r][i].y + v[r][i].z * v[r][i].z + v[r][i].w * v[r][i].w;
            s2 = wave_sum(s2);
            if (lane < 4) *(f32x4*)(ss + (size_t)(row0 + r) * 16 + 4 * lane) = (f32x4){lane == 0 ? s2 : 0.f, 0.f, 0.f, 0.f};
#pragma unroll
            for (int i = 0; i < 4; ++i) { uint2 w; w.x = pack_bf16(v[r][i].x, v[r][i].y); w.y = pack_bf16(v[r][i].z, v[r][i].w); *(uint2*)(h + (size_t)(row0 + r) * D + (i * 64 + lane) * 4) = w; }
        }
    }
}
DI void final_norm_phase(const bf16_t* __restrict__ h, const float* __restrict__ ss, float* __restrict__ out, const float* __restrict__ g, int rows) {
    const int tid = otid(), wave = tid >> 6, lane = tid & 63;
    constexpr int RB = 8;
    float gg[16];
#pragma unroll
    for (int i = 0; i < 4; ++i) { const float4 a = ((const float4*)g)[lane * 4 + i]; gg[4 * i] = a.x; gg[4 * i + 1] = a.y; gg[4 * i + 2] = a.z; gg[4 * i + 3] = a.w; }
    for (int row0 = (blockIdx.x * 8 + wave) * RB; row0 < rows; row0 += gridDim.x * 8 * RB) {
        u32x4 v[RB][2]; float sp[RB];
#pragma unroll
        for (int r = 0; r < RB; ++r) {
            const bf16_t* hp = h + (size_t)(row0 + r) * D + lane * 16;
            v[r][0] = *(const u32x4*)hp; v[r][1] = *(const u32x4*)(hp + 8);
            sp[r] = ss[(size_t)(row0 + r) * 16 + (lane & 15)];
        }
#pragma unroll
        for (int r = 0; r < RB; ++r) {
            float s = sp[r]; s += shx(s, 1); s += shx(s, 2); s += shx(s, 4); s += shx(s, 8);
            const float rstd = rsqrtf(s * (1.0f / D) + 1e-6f);
            float f[16]; unpack8(v[r][0], f); unpack8(v[r][1], f + 8);
            float* op = out + (size_t)(row0 + r) * D + lane * 16;
#pragma unroll
            for (int i = 0; i < 4; ++i) { float4 o; o.x = f[4 * i] * rstd * gg[4 * i]; o.y = f[4 * i + 1] * rstd * gg[4 * i + 1]; o.z = f[4 * i + 2] * rstd * gg[4 * i + 2]; o.w = f[4 * i + 3] * rstd * gg[4 * i + 3]; ((float4*)op)[i] = o; }
        }
    }
}

DI void rotary_phase(bf16_t* P, int T, int ld, int col0, int nheads, int hd, const float2* __restrict__ tab) {
    const int half = hd >> 1, cpr = half >> 3, per_tok = nheads * cpr;
    const int total = T * per_tok, stride = gridDim.x * NTHR;
    for (int it0 = blockIdx.x * NTHR + otid(); it0 < total; it0 += 2 * stride) {
        bf16_t* base[2]; u32x4 a[2], bb[2]; float4 cs[2][4];
#pragma unroll
        for (int u = 0; u < 2; ++u) {
            const int it = (it0 + u * stride < total) ? it0 + u * stride : it0;
            const int tok = it / per_tok, r = it - tok * per_tok, hh = r / cpr, ch = r - hh * cpr, pos = tok & (SEQ - 1);
            base[u] = P + (size_t)tok * ld + col0 + hh * hd + ch * 8;
            a[u] = *(const u32x4*)base[u]; bb[u] = *(const u32x4*)(base[u] + half);
            const float4* tp = (const float4*)(tab + (size_t)pos * half + ch * 8);
#pragma unroll
            for (int j = 0; j < 4; ++j) cs[u][j] = tp[j];
        }
#pragma unroll
        for (int u = 0; u < 2; ++u) {
            u32x4 oa, ob;
#pragma unroll
            for (int j = 0; j < 4; ++j) {
                const float4 c = cs[u][j];
                const float x1l = bf_lo(a[u][j]), x1h = bf_hi(a[u][j]), x2l = bf_lo(bb[u][j]), x2h = bf_hi(bb[u][j]);
                oa[j] = pack_bf16(x1l * c.x - x2l * c.y, x1h * c.z - x2h * c.w);
                ob[j] = pack_bf16(x1l * c.y + x2l * c.x, x1h * c.w + x2h * c.z);
            }
            if (u == 0 || it0 + stride < total) { *(u32x4*)base[u] = oa; *(u32x4*)(base[u] + half) = ob; }
        }
    }
}

constexpr int ATT_RSV = 192;
constexpr int ATT_RPB_OFF = 64  , ATT_V_OFF = 16384, ATT_V_BYTES = 32 * ATT_RSV, ATT_W_BYTES = ATT_V_BYTES + 4096  ;
DI int crow(int reg, int h) { return (reg & 3) + 8 * (reg >> 2) + 4 * h; }

struct NaMask { LAS float* rp; int e0, b0; DI float operator()(int ic, float s) const { const float bias = rp[b0 + ic]; return (unsigned)(e0 + ic) < 16u ? s + bias : -1e30f; } };
struct DilMask { int e0; DI float operator()(int ic, float s) const { return (unsigned)(e0 + ic) <= 128u ? s : -1e30f; } };
struct DilMaskEdge { int e0, m0h, Lm; DI float operator()(int ic, float s) const { const bool ok = ((unsigned)(e0 + ic) <= 128u) && ((unsigned)(m0h + ic) < (unsigned)Lm); return ok ? s : -1e30f; } };

DI f32x16 attn_scores(LAS unsigned char* LQ, int lane, const bf16x8 (&kf)[4]) {
    f32x16 S;
#pragma unroll
    for (int i = 0; i < 16; ++i) S[i] = 0.f;
#pragma unroll
    for (int c = 0; c < 4; ++c) S = mfma32(kf[c], lds_r128(LQ, c * 1024 + lane * 16), S);
    return S;
}
template <class MaskF>
DI void attn_rest(const f32x16& S, LAS unsigned char* LV, int lane, f32x16& O0, f32x16& O1, float& m_run, float& l_run, const MaskF& maskf) {
    const int h = lane >> 5;
    float sv[16]; float mx = -1e30f;
#pragma unroll
    for (int r = 0; r < 16; ++r) { sv[r] = maskf((r & 3) + 8 * (r >> 2), S[r]); mx = fmaxf(mx, sv[r]); }
    mx = fmaxf(mx, shx(mx, 32));
    if (__builtin_amdgcn_ballot_w64(mx > m_run) != 0ull) {
        const float mn = fmaxf(m_run, mx);
        const float alpha = fexp2(m_run - mn);
        m_run = mn; l_run *= alpha;
#pragma unroll
        for (int i = 0; i < 16; ++i) { O0[i] *= alpha; O1[i] *= alpha; }
    }
    float ps = 0.f;
#pragma unroll
    for (int r = 0; r < 16; ++r) { const float p = fexp2(sv[r] - m_run); sv[r] = p; ps += p; }
    l_run += ps;
    const int i16 = lane & 15, q4 = i16 >> 2, p4 = i16 & 3, blk = (lane >> 4) & 1;
#pragma unroll
    for (int s = 0; s < 2; ++s) {
        const bf16x8 pf = pack8(&sv[8 * s]);
        const int r0 = 16 * s + 4 * h + q4, cb = 2 * (16 * blk + 4 * p4);
        const s16x4 lo0 = lds_tr(LV, r0 * ATT_RSV + cb), hi0 = lds_tr(LV, (r0 + 8) * ATT_RSV + cb);
        const s16x4 lo1 = lds_tr(LV, r0 * ATT_RSV + 64 + cb), hi1 = lds_tr(LV, (r0 + 8) * ATT_RSV + 64 + cb);
        O0 = mfma32(cat4(lo0, hi0), pf, O0);
        O1 = mfma32(cat4(lo1, hi1), pf, O1);
    }
}
DI void attn_load_k(const bf16_t* P, size_t tokbase, int ld, int kcol, int Dk, int rD, int Lm, int m0, int lane, bf16x8 (&kn)[4]) {
    const int h = lane >> 5;
    int m = m0 + (lane & 31); m = m < 0 ? 0 : (m > Lm - 1 ? Lm - 1 : m);
    const bf16_t* kp = P + (tokbase + (size_t)(Dk * m + rD)) * ld + kcol + 8 * h;
#pragma unroll
    for (int c = 0; c < 4; ++c) kn[c] = *(const bf16x8*)(kp + 16 * c);
}
DI void attn_load_v(const bf16_t* P, size_t tokbase, int ld, int vcol, int Dk, int rD, int Lm, int m0, int lane, bf16x8 (&vn)[4]) {
#pragma unroll
    for (int it = 0; it < 4; ++it) { int m = m0 + it * 8 + (lane >> 3); m = m < 0 ? 0 : (m > Lm - 1 ? Lm - 1 : m);
        vn[it] = *(const bf16x8*)(P + (tokbase + (size_t)(Dk * m + rD)) * ld + vcol + (lane & 7) * 8); }
}
DI void attn_store_v(LAS unsigned char* LV, int lane, const bf16x8 (&vn)[4]) {
    asm volatile("" ::: "memory");
#pragma unroll
    for (int it = 0; it < 4; ++it) lds_w128(LV, (it * 8 + (lane >> 3)) * ATT_RSV + (lane & 7) * 16, vn[it]);
    __builtin_amdgcn_wave_barrier();
    asm volatile("" ::: "memory");
}
DI void attn_finish(bf16_t* orow, int lane, const f32x16& O0, const f32x16& O1, float l_run) {
    const int h = lane >> 5;
    const float lt = l_run + shx(l_run, 32);
    const float inv = 1.0f / lt;
#pragma unroll
    for (int g = 0; g < 4; ++g) {
        uint2 w0, w1;
        w0.x = pack_bf16(O0[4 * g] * inv, O0[4 * g + 1] * inv); w0.y = pack_bf16(O0[4 * g + 2] * inv, O0[4 * g + 3] * inv);
        w1.x = pack_bf16(O1[4 * g] * inv, O1[4 * g + 1] * inv); w1.y = pack_bf16(O1[4 * g + 2] * inv, O1[4 * g + 3] * inv);
        *(uint2*)(orow + 8 * g + 4 * h) = w0;
        *(uint2*)(orow + 32 + 8 * g + 4 * h) = w1;
    }
}
struct NaDesc {
    const bf16_t* P; size_t tokbase; LAS float* rp; int lane, kcol, vcol, rsA, c0, qr, qc, rs, cs;
    DI void loadk(int t, bf16x8 (&kn)[4]) const { attn_load_k(P, tokbase, EIN, kcol, 1, 0, SEQ, (rsA + t) * 64 + c0, lane, kn); }
    DI void loadv(int t, bf16x8 (&vn)[4]) const { attn_load_v(P, tokbase, EIN, vcol, 1, 0, SEQ, (rsA + t) * 64 + c0, lane, vn); }
    DI void rest(int t, const f32x16& S, LAS unsigned char* LV, int ln, f32x16& O0, f32x16& O1, float& m_run, float& l_run) const { attn_rest(S, LV, ln, O0, O1, m_run, l_run, mask(t)); }
    DI NaMask mask(int t) const { const int kr = rsA + t, h4 = 4 * (lane >> 5); const bool rowok = (kr >= rs) && (kr < rs + 8); return NaMask{rp, rowok ? c0 - cs + h4 : (1 << 20), (kr - qr + 7) * 31 + c0 - qc + 15 + h4}; }
};
struct DilDesc {
    const bf16_t* P; size_t tokbase; int lane, kcol, vcol, mblk, r, tq;
    DI static int sh_of(int T) { return T < 20 ? 0 : (T < 28 ? 2 : 4); }
    DI static int tt_of(int T) { return T < 20 ? T : (T < 28 ? T - 20 : T - 28); }
    DI int m0_of(int T) const { const int sh = sh_of(T); return ((512 * mblk) >> sh) - 64 + 32 * tt_of(T); }
    DI void loadk(int T, bf16x8 (&kn)[4]) const { const int sh = sh_of(T); attn_load_k(P, tokbase, EIN, kcol, 1 << sh, r & ((1 << sh) - 1), SEQ >> sh, m0_of(T), lane, kn); }
    DI void loadv(int T, bf16x8 (&vn)[4]) const { const int sh = sh_of(T); attn_load_v(P, tokbase, EIN, vcol, 1 << sh, r & ((1 << sh) - 1), SEQ >> sh, m0_of(T), lane, vn); }
    DI void rest(int T, const f32x16& S, LAS unsigned char* LV, int ln, f32x16& O0, f32x16& O1, float& m_run, float& l_run) const {
        if (is_edge(T)) attn_rest(S, LV, ln, O0, O1, m_run, l_run, mask_edge(T)); else attn_rest(S, LV, ln, O0, O1, m_run, l_run, mask(T)); }
    DI DilMask mask(int T) const { const int sh = sh_of(T); return DilMask{m0_of(T) - (tq >> sh) + 64 + 4 * (lane >> 5)}; }
    DI DilMaskEdge mask_edge(int T) const { const int sh = sh_of(T), h4 = 4 * (lane >> 5); return DilMaskEdge{m0_of(T) - (tq >> sh) + 64 + h4, m0_of(T) + h4, SEQ >> sh}; }
    DI bool is_edge(int T) const { const int m0 = m0_of(T); return (m0 < 0) || (m0 + 32 > (SEQ >> sh_of(T))); }
};
template <class Desc>
DI void attn_loop(const Desc& d, int ntiles, const bf16x8 (&qf)[4], LAS unsigned char* LV, int lane, bf16_t* orow) {
    LAS unsigned char* LQ = LV + ATT_V_BYTES;
    asm volatile("" ::: "memory");
#pragma unroll
    for (int c = 0; c < 4; ++c) lds_w128(LQ, c * 1024 + lane * 16, qf[c]);
    asm volatile("" ::: "memory");
    f32x16 O0, O1;
#pragma unroll
    for (int i = 0; i < 16; ++i) { O0[i] = 0.f; O1[i] = 0.f; }
    float m_run = -1e30f, l_run = 0.f;
    bf16x8 kA[4], kB[4], vN[4];
    const int tl = ntiles - 1;
    d.loadk(0, kA); d.loadv(0, vN); d.loadk(1 < tl ? 1 : tl, kB);
#pragma unroll 1
    for (int t = 0; t + 1 < ntiles; t += 2) {
        const f32x16 Sa = attn_scores(LQ, lane, kA);
        d.loadk(t + 2 < tl ? t + 2 : tl, kA);
        attn_store_v(LV, lane, vN);
        d.loadv(t + 1, vN);
        d.rest(t, Sa, LV, lane, O0, O1, m_run, l_run);
        const f32x16 Sb = attn_scores(LQ, lane, kB);
        d.loadk(t + 3 < tl ? t + 3 : tl, kB);
        attn_store_v(LV, lane, vN);
        d.loadv(t + 2 < tl ? t + 2 : tl, vN);
        d.rest(t + 1, Sb, LV, lane, O0, O1, m_run, l_run);
    }
    if (ntiles & 1) {
        const f32x16 Sa = attn_scores(LQ, lane, kA);
        attn_store_v(LV, lane, vN);
        d.rest(tl, Sa, LV, lane, O0, O1, m_run, l_run);
    }
    attn_finish(orow, lane, O0, O1, l_run);
}
DI void na_item(int item, const bf16_t* P, bf16_t* Oo, LAS float* rpbL, LAS unsigned char* LV, int lane) {
    const int cb = item & 3, rp = (item >> 2) & 31, head = (item >> 7) & 7, seq = item >> 10;
    const size_t tokbase = (size_t)seq * SEQ;
    const int h = lane >> 5, j = lane & 31, qr = 2 * rp + (j >> 4), qc = 16 * cb + (j & 15), tq = qr * 64 + qc;
    bf16x8 qf[4];
    { const bf16_t* qp = P + (tokbase + tq) * EIN + head * 64 + 8 * h;
#pragma unroll
      for (int c = 0; c < 4; ++c) qf[c] = *(const bf16x8*)(qp + 16 * c); }
    int rs = qr - 4; rs = rs < 0 ? 0 : (rs > 56 ? 56 : rs);
    int cs = qc - 8; cs = cs < 0 ? 0 : (cs > 48 ? 48 : cs);
    int rsA = 2 * rp - 4; rsA = rsA < 0 ? 0 : (rsA > 56 ? 56 : rsA);
    int rsB = 2 * rp - 3; rsB = rsB < 0 ? 0 : (rsB > 56 ? 56 : rsB);
    const int c0 = cb == 0 ? 0 : (cb == 1 ? 8 : (cb == 2 ? 24 : 32));
    const NaDesc d{P, tokbase, rpbL + head * 465, lane, 512 + head * 64, 1024 + head * 64, rsA, c0, qr, qc, rs, cs};
    attn_loop(d, rsB + 8 - rsA, qf, LV, lane, Oo + (tokbase + tq) * D + head * 64);
}
DI void dil_item(int item, const bf16_t* P, bf16_t* Oo, LAS unsigned char* LV, int lane) {
    const int mblk = item & 7, r = (item >> 3) & 15, head = (item >> 7) & 7, seq = item >> 10;
    const size_t tokbase = (size_t)seq * SEQ;
    const int h = lane >> 5, tq = 16 * (32 * mblk + (lane & 31)) + r;
    bf16x8 qf[4];
    { const bf16_t* qp = P + (tokbase + tq) * EIN + 1536 + head * 64 + 8 * h;
#pragma unroll
      for (int c = 0; c < 4; ++c) qf[c] = *(const bf16x8*)(qp + 16 * c); }
    const DilDesc d{P, tokbase, lane, 2048 + head * 64, 2560 + head * 64, mblk, r, tq};
    attn_loop(d, 33, qf, LV, lane, Oo + (tokbase + tq) * D + 512 + head * 64);
}
DI void attn_phase(LAS unsigned char* L, const bf16_t* P, bf16_t* Oo, const float* rpb, int nseq) {
    LAS float* rpbL = (LAS float*)(L + ATT_RPB_OFF);
    const int tid = otid();
    for (int i = tid; i < 8 * 465; i += NTHR) rpbL[i] = rpb[i] * LOG2E;
    __syncthreads();
    const int wave = tid >> 6, lane = tid & 63;
    LAS unsigned char* LV = L + ATT_V_OFF + wave * ATT_W_BYTES;
    const int nitems = nseq * 1024, nw = gridDim.x * 8;
    for (int it = vblock() * 8 + wave; it < 2 * nitems; it += nw) {
        if (it < nitems) na_item(it, P, Oo, rpbL, LV, lane);
        else dil_item(it - nitems, P, Oo, LV, lane);
    }
    __syncthreads();
}

DI void conv_phase(const bf16_t* __restrict__ A, bf16_t* __restrict__ Oo, const float* __restrict__ cw, const float* __restrict__ cb, int T) {
    constexpr int TB = 8, NCH = FF / 8;
    const int total = (T / TB) * NCH;
    for (int it = blockIdx.x * NTHR + otid(); it < total; it += gridDim.x * NTHR) {
        const int tb = it / NCH, fc = it - tb * NCH, t0 = tb * TB, f0 = fc * 8;
        const bf16_t* ap = A + (size_t)t0 * F2 + f0;
        const bool first = (t0 & (SEQ - 1)) == 0, last = ((t0 + TB) & (SEQ - 1)) == 0;
        u32x4 ru[TB + 2], rg[TB + 2];
#pragma unroll
        for (int r = 0; r < TB + 2; ++r) {
            const bool zero = (r == 0 && first) || (r == TB + 1 && last);
            const bf16_t* rp = ap + (ptrdiff_t)(zero ? 0 : r - 1) * F2;
            ru[r] = *(const u32x4*)rp; rg[r] = *(const u32x4*)(rp + FF);
            if (zero) { ru[r] = (u32x4){0u, 0u, 0u, 0u}; rg[r] = (u32x4){0u, 0u, 0u, 0u}; }
        }
        float wu[3][8], wg[3][8], bu[8], bg[8];
#pragma unroll
        for (int j = 0; j < 3; ++j)
#pragma unroll
            for (int e = 0; e < 8; e += 4) { const float4 a = *(const float4*)(cw + (size_t)j * F2 + f0 + e), c = *(const float4*)(cw + (size_t)j * F2 + FF + f0 + e);
                wu[j][e] = a.x; wu[j][e + 1] = a.y; wu[j][e + 2] = a.z; wu[j][e + 3] = a.w; wg[j][e] = c.x; wg[j][e + 1] = c.y; wg[j][e + 2] = c.z; wg[j][e + 3] = c.w; }
#pragma unroll
        for (int e = 0; e < 8; e += 4) { const float4 a = *(const float4*)(cb + f0 + e), c = *(const float4*)(cb + FF + f0 + e);
            bu[e] = a.x; bu[e + 1] = a.y; bu[e + 2] = a.z; bu[e + 3] = a.w; bg[e] = c.x; bg[e + 1] = c.y; bg[e + 2] = c.z; bg[e + 3] = c.w; }
        float pu[8], pg[8], cu[8], cg_[8], nu[8], ng[8];
        unpack8(ru[0], pu); unpack8(rg[0], pg); unpack8(ru[1], cu); unpack8(rg[1], cg_);
#pragma unroll
        for (int r = 0; r < TB; ++r) {
            unpack8(ru[r + 2], nu); unpack8(rg[r + 2], ng);
            float o[8];
#pragma unroll
            for (int e = 0; e < 8; ++e) {
                const float yu = bu[e] + pu[e] * wu[0][e] + cu[e] * wu[1][e] + nu[e] * wu[2][e];
                const float yg = bg[e] + pg[e] * wg[0][e] + cg_[e] * wg[1][e] + ng[e] * wg[2][e];
                o[e] = yu * gelu_tanh(yg);
                pu[e] = cu[e]; pg[e] = cg_[e]; cu[e] = nu[e]; cg_[e] = ng[e];
            }
            *(bf16x8*)(Oo + (size_t)(t0 + r) * FF + f0) = pack8(o);
        }
    }
}

constexpr int RT_RSQ = 528, RT_RSV = 144;
constexpr int RT_OQ = 0, RT_OK = 64 * RT_RSQ, RT_OS = 2 * 64 * RT_RSQ, RT_OV = 3 * 64 * RT_RSQ  , RT_OVK = RT_OV + 2 * 64 * RT_RSV, RT_OP = RT_OVK + 64 * RT_RSV, RT_END = RT_OP + 64 * RT_RSV;
static_assert(RT_END <= LDS_BYTES - 16, "retention LDS");
DI float softplus_f(float x) { return x > 20.f ? x : log1pf(expf(x)); }
DI void ret_issue(const bf16_t* qg, const bf16_t* kg, const bf16_t* vg, size_t tok0, int tid, bf16x8 (&sq)[4], bf16x8 (&sk)[4], bf16x8& sv) {
#pragma unroll
    for (int i = 0; i < 4; ++i) { const int idx = tid + NTHR * i, row = idx >> 5, ch = idx & 31; const size_t o = (tok0 + row) * RIN + ch * 8; sq[i] = *(const bf16x8*)(qg + o); sk[i] = *(const bf16x8*)(kg + o); }
    { const int row = tid >> 3, ch = tid & 7; sv = *(const bf16x8*)(vg + (tok0 + row) * RIN + ch * 8); }
}
DI void ret_stage(LAS unsigned char* L, int tid, int vbuf, float kd, const bf16x8 (&sq)[4], const bf16x8 (&sk)[4], const bf16x8& sv) {
#pragma unroll
    for (int i = 0; i < 4; ++i) { const int idx = tid + NTHR * i, row = idx >> 5, ch = idx & 31; lds_w128(L, RT_OQ + row * RT_RSQ + ch * 16, sq[i]); lds_w128(L, RT_OK + row * RT_RSQ + ch * 16, sk[i]); }
    const int row = tid >> 3, ch = tid & 7;
    lds_w128(L, RT_OV + vbuf * 64 * RT_RSV + row * RT_RSV + ch * 16, sv);
    float f[8]; unpack8(__builtin_bit_cast(u32x4, sv), f);
#pragma unroll
    for (int e = 0; e < 8; ++e) f[e] *= kd;
    lds_w128(L, RT_OVK + row * RT_RSV + ch * 16, pack8(f));
}
DI void ret_phase(LAS unsigned char* L, const bf16_t* P, bf16_t* R, const float* lg2tab, int nseq) {
    const int tid = otid(), wave = __builtin_amdgcn_readfirstlane(tid >> 6), lane = tid & 63, l15 = lane & 15, quad = lane >> 4, q4 = l15 >> 2, p4 = l15 & 3;
    const int xb = wave & 3, wh = wave >> 2;
    for (int item = vblock(); item < nseq * 64; item += gridDim.x) {
        const int vs = item & 7, dir = (item >> 3) & 1, hh = (item >> 4) & 3, seq = item >> 6;
        const float lg2 = lg2tab[dir * 4 + hh];
        int oz = 0; asm volatile("" : "+v"(oz));
        const size_t tokbase = (size_t)seq * SEQ;
        const bf16_t* qg = P + hh * 256; const bf16_t* kg = P + 1024 + hh * 256; const bf16_t* vg = P + 2048 + hh * 512 + vs * 64;
        bf16_t* rout = R + (size_t)dir * TG * RMIX + hh * 512 + vs * 64;
        bf16x8 sq[4], sk[4], sv;
        ret_issue(qg, kg, vg, tokbase + (size_t)(dir ? 63 : 0) * 64, tid, sq, sk, sv);
        __syncthreads();
        { const unsigned z = (unsigned)oz; const u32x4 zz = {z, z, z, z};
          for (int i = tid; i < 64 * RT_RSQ / 16; i += NTHR) *(LAS u32x4*)(L + RT_OS + i * 16) = zz; }
        f32x4 st[8];
#pragma unroll
        for (int j = 0; j < 8; ++j) st[j] = (f32x4){0.f, 0.f, 0.f, 0.f};
        float qd[2][4];
#pragma unroll
        for (int t = 0; t < 2; ++t)
#pragma unroll
            for (int r = 0; r < 4; ++r) { const int q = (2 * wh + t) * 16 + 4 * quad + r + oz; qd[t][r] = fexp2(lg2 * (float)(dir ? 64 - q : q + 1)); }
        const float sd = fexp2(lg2 * 64.f);
        const float kdv = fexp2(lg2 * (float)(dir ? (tid >> 3) + oz : 63 - (tid >> 3) + oz));
        float dm[2][4];
#pragma unroll
        for (int t = 0; t < 2; ++t)
#pragma unroll
            for (int r = 0; r < 4; ++r) { const int q = (2 * wh + t) * 16 + l15 + oz, key = xb * 16 + 4 * quad + r; const int diff = dir ? key - q : q - key; const bool ok = dir ? (diff > 0) : (diff >= 0); dm[t][r] = ok ? fexp2(lg2 * (float)diff) : 0.f; }
        ret_stage(L, tid, 0, kdv, sq, sk, sv);
        __syncthreads();
#pragma unroll 1
        for (int step = 0; step < 64; ++step) {
            const int c = dir ? 63 - step : step, cur = step & 1;
            int lo_ = lane; asm volatile("" : "+v"(lo_));
            const int l15 = lo_ & 15, quad = lo_ >> 4, q4 = l15 >> 2, p4 = l15 & 3;
            if (step + 1 < 64) ret_issue(qg, kg, vg, tokbase + (size_t)(dir ? 62 - step : step + 1) * 64, tid, sq, sk, sv);
            bf16x8 qa[2][8];
#pragma unroll
            for (int s = 0; s < 8; ++s) {
                const int ko = (32 * s + 8 * quad) * 2;
                qa[0][s] = lds_r128(L, RT_OQ + ((2 * wh) * 16 + l15) * RT_RSQ + ko); qa[1][s] = lds_r128(L, RT_OQ + ((2 * wh + 1) * 16 + l15) * RT_RSQ + ko);
            }
            f32x4 s0 = (f32x4){0.f, 0.f, 0.f, 0.f}, s1 = s0;
#pragma unroll
            for (int hs = 0; hs < 2; ++hs) {
                bf16x8 xa[4];
#pragma unroll
                for (int s = 0; s < 4; ++s) xa[s] = lds_r128(L, RT_OK + (xb * 16 + l15) * RT_RSQ + (32 * (4 * hs + s) + 8 * quad) * 2);
#pragma unroll
                for (int s = 0; s < 4; ++s) { s0 = mfma16(xa[s], qa[0][4 * hs + s], s0); s1 = mfma16(xa[s], qa[1][4 * hs + s], s1); }
            }
#pragma unroll
            for (int t = 0; t < 2; ++t) {
                const f32x4 sx = t ? s1 : s0;
                const int q = (2 * wh + t) * 16 + l15, key0 = xb * 16 + 4 * quad;
                u32x2 w; w.x = pack_bf16(sx[0] * dm[t][0], sx[1] * dm[t][1]); w.y = pack_bf16(sx[2] * dm[t][2], sx[3] * dm[t][3]);
                *(LAS u32x2*)(L + RT_OP + q * RT_RSV + key0 * 2) = w;
            }
            f32x4 o0 = (f32x4){0.f, 0.f, 0.f, 0.f}, o1 = o0;
#pragma unroll
            for (int hs = 0; hs < 2; ++hs) {
                bf16x8 xa[4];
#pragma unroll
                for (int s = 0; s < 4; ++s) xa[s] = lds_r128(L, RT_OS + (xb * 16 + l15) * RT_RSQ + (32 * (4 * hs + s) + 8 * quad) * 2);
#pragma unroll
                for (int s = 0; s < 4; ++s) { o0 = mfma16(qa[0][4 * hs + s], xa[s], o0); o1 = mfma16(qa[1][4 * hs + s], xa[s], o1); }
            }
#pragma unroll
            for (int r = 0; r < 4; ++r) { o0[r] *= qd[0][r]; o1[r] *= qd[1][r]; }
#pragma unroll
            for (int j = 0; j < 8; ++j) st[j] *= sd;
#pragma unroll
            for (int s = 0; s < 2; ++s) {
                const int kr = 32 * s + 8 * quad + q4;
                const bf16x8 bv = cat4(lds_tr(L, RT_OVK + kr * RT_RSV + (xb * 16 + 4 * p4) * 2), lds_tr(L, RT_OVK + (kr + 4) * RT_RSV + (xb * 16 + 4 * p4) * 2));
#pragma unroll
                for (int hj = 0; hj < 2; ++hj) {
                    bf16x8 ak[4];
#pragma unroll
                    for (int j = 0; j < 4; ++j) { const int db = 8 * wh + 4 * hj + j; ak[j] = cat4(lds_tr(L, RT_OK + kr * RT_RSQ + (db * 16 + 4 * p4) * 2), lds_tr(L, RT_OK + (kr + 4) * RT_RSQ + (db * 16 + 4 * p4) * 2)); }
#pragma unroll
                    for (int j = 0; j < 4; ++j) st[4 * hj + j] = mfma16(ak[j], bv, st[4 * hj + j]);
                }
            }
            __syncthreads();
            if (step + 1 < 64) ret_stage(L, tid, cur ^ 1, kdv, sq, sk, sv);
#pragma unroll
            for (int s = 0; s < 2; ++s) {
                const int kr = 32 * s + 8 * quad + q4, ko = (32 * s + 8 * quad) * 2;
                const bf16x8 bv = cat4(lds_tr(L, RT_OV + cur * 64 * RT_RSV + kr * RT_RSV + (xb * 16 + 4 * p4) * 2), lds_tr(L, RT_OV + cur * 64 * RT_RSV + (kr + 4) * RT_RSV + (xb * 16 + 4 * p4) * 2));
                const bf16x8 a0 = lds_r128(L, RT_OP + ((2 * wh) * 16 + l15) * RT_RSV + ko), a1 = lds_r128(L, RT_OP + ((2 * wh + 1) * 16 + l15) * RT_RSV + ko);
                o0 = mfma16(a0, bv, o0); o1 = mfma16(a1, bv, o1);
            }
#pragma unroll
            for (int t = 0; t < 2; ++t)
#pragma unroll
                for (int r = 0; r < 4; ++r) {
                    const int q = (2 * wh + t) * 16 + 4 * quad + r;
                    const float val = t ? o1[r] : o0[r];
                    rout[(tokbase + (size_t)c * 64 + q) * RMIX + xb * 16 + l15] = (bf16_t)(pack_bf16(val, 0.f) & 0xffffu);
                }
#pragma unroll
            for (int j = 0; j < 8; ++j) { const int db = 8 * wh + j; u32x2 w; w.x = pack_bf16(st[j][0], st[j][1]); w.y = pack_bf16(st[j][2], st[j][3]);
                *(LAS u32x2*)(L + RT_OS + (xb * 16 + l15) * RT_RSQ + (db * 16 + 4 * quad) * 2) = w; }
            __syncthreads();
        }
    }
    __syncthreads();
}
DI void ret_combine_phase(const bf16_t* __restrict__ R, const bf16_t* __restrict__ P, bf16_t* __restrict__ Oo, int T) {
    const int tid = otid(), wave = tid >> 6, lane = tid & 63;
    const int stride = gridDim.x * 8;
    for (int it0 = blockIdx.x * 8 + wave; it0 < T * 4; it0 += 2 * stride) {
        u32x4 ra[2], rb[2], rg[2]; size_t off[2];
#pragma unroll
        for (int u = 0; u < 2; ++u) {
            const int it = (it0 + u * stride < T * 4) ? it0 + u * stride : it0, tok = it >> 2, hh = it & 3;
            off[u] = (size_t)tok * RMIX + hh * 512 + lane * 8;
            ra[u] = *(const u32x4*)(R + off[u]); rb[u] = *(const u32x4*)(R + (size_t)TG * RMIX + off[u]);
            rg[u] = *(const u32x4*)(P + (size_t)tok * RIN + 4096 + hh * 512 + lane * 8);
        }
#pragma unroll
        for (int u = 0; u < 2; ++u) {
            float a[8], c[8], g[8];
            unpack8(ra[u], a); unpack8(rb[u], c); unpack8(rg[u], g);
            float s = 0.f;
#pragma unroll
            for (int e = 0; e < 8; ++e) { a[e] += c[e]; s += a[e]; }
            const float mu = wave_sum(s) * (1.0f / 512.f);
            float v = 0.f;
#pragma unroll
            for (int e = 0; e < 8; ++e) { a[e] -= mu; v += a[e] * a[e]; }
            const float rstd = rsqrtf(wave_sum(v) * (1.0f / 512.f) + 1e-6f);
            float o[8];
#pragma unroll
            for (int e = 0; e < 8; ++e) { const float sg = g[e] / (1.0f + __expf(-g[e])); o[e] = sg * a[e] * rstd; }
            *(bf16x8*)(Oo + off[u]) = pack8(o);
        }
    }
}

#define XB_TMO      128
#define XB_XCNT(j)  (256  + 64 * (j))
#define XB_XSUB(j)  (1280 + 64 * (j))
#define XB_XGEN(j)  (2304 + 64 * (j))
#define XB_TOP      3328
#define XB_TOPGEN   3392
#define XCD_BAR_WORDS 3456
#define XB_SPIN_CAP (1u << 22)
DI unsigned xb_ld(unsigned* p)              { return __hip_atomic_load(p, __ATOMIC_RELAXED, __HIP_MEMORY_SCOPE_AGENT); }
DI unsigned xb_add(unsigned* p, unsigned v) { return __hip_atomic_fetch_add(p, v, __ATOMIC_RELAXED, __HIP_MEMORY_SCOPE_AGENT); }
DI unsigned xb_xcc_id() { return (unsigned)__builtin_amdgcn_s_getreg((3 << 11) | 20) & 0xFu; }
#define XB_SPIN(cond, bar) do { unsigned _sp = 0; while (cond) { __builtin_amdgcn_s_sleep(1); \
    if ((++_sp & 255u) == 0u) { if (xb_ld(&(bar)[XB_TMO])) break; if (_sp > XB_SPIN_CAP) { atomicAdd(&(bar)[XB_TMO], 1u); break; } } } } while (0)
struct XcdBarrier { unsigned* bar; unsigned x; volatile LAS unsigned* st; };
DI XcdBarrier xcd_barrier_post(unsigned* bar, volatile LAS unsigned* st) {
    XcdBarrier b; b.bar = bar; b.x = xb_xcc_id(); b.st = st;
    if (raw_tid() == 0) (void)xb_add(&bar[XB_XCNT(b.x)], 1u);
    return b;
}
DI void xcd_barrier_complete(unsigned* bar, unsigned x, unsigned& nloc, unsigned& nx) {
    const unsigned G = gridDim.x * gridDim.y * gridDim.z;
    unsigned sum, cnt, mine, sp = 0u;
    for (;;) {
        sum = 0u; cnt = 0u; mine = 0u;
#pragma unroll 1
        for (unsigned j = 0; j < 16; ++j) { const unsigned c = xb_ld(&bar[XB_XCNT(j)]); sum += c; cnt += (c > 0u) ? 1u : 0u; mine = (j == x) ? c : mine; }
        if (sum == G) break;
        __builtin_amdgcn_s_sleep(1);
        if ((++sp & 255u) == 0u) { if (xb_ld(&bar[XB_TMO])) break; if (sp > XB_SPIN_CAP) { atomicAdd(&bar[XB_TMO], 1u); break; } }
    }
    nloc = mine > 0u ? mine : 1u; nx = cnt > 0u ? cnt : 1u;
}
DI void xcd_barrier(const XcdBarrier& b) {
    asm volatile("s_waitcnt vmcnt(0)" ::: "memory");
    __syncthreads();
    if (raw_tid() == 0) {
        unsigned* bar = b.bar;
        __builtin_amdgcn_s_waitcnt(0);
        unsigned nloc = b.st[0], nx = b.st[1];
        if (nloc == 0u) { xcd_barrier_complete(bar, b.x, nloc, nx); b.st[0] = nloc; b.st[1] = nx; }
        const unsigned old = xb_add(&bar[XB_XSUB(b.x)], 1u);
        const unsigned gen = old / nloc;
        if (old + 1u == (gen + 1u) * nloc) {
            __builtin_amdgcn_fence(__ATOMIC_RELEASE, "agent");
            asm volatile("s_waitcnt vmcnt(0)" ::: "memory");
            const unsigned og = xb_add(&bar[XB_TOP], 1u);
            const unsigned tg = og / nx;
            if (og + 1u == (tg + 1u) * nx) xb_add(&bar[XB_TOPGEN], 1u);
            else XB_SPIN(xb_ld(&bar[XB_TOPGEN]) == tg, bar);
            __builtin_amdgcn_fence(__ATOMIC_ACQUIRE, "agent");
            xb_add(&bar[XB_XGEN(b.x)], 1u);
            asm volatile("s_waitcnt vmcnt(0)" ::: "memory");
        } else {
            XB_SPIN(xb_ld(&bar[XB_XGEN(b.x)]) == gen, bar);
            __builtin_amdgcn_fence(__ATOMIC_ACQUIRE, "agent");
            asm volatile("s_waitcnt vmcnt(0)" ::: "memory");
        }
    }
    __syncthreads();
}

typedef __attribute__((address_space(1))) unsigned char* gptr_t;
DI gptr_t ws_op(unsigned char* w) { gptr_t g = (gptr_t)w; asm volatile("" : "+s"(g)); return g; }
__global__ void __launch_bounds__(NTHR, 2) mega_fwd(Params p) {
    extern __shared__ __attribute__((aligned(16))) unsigned char shm[];
    LAS unsigned char* L = (LAS unsigned char*)shm;
    cg::grid_group grid = cg::this_grid();
    unsigned char* ws = p.ws;
    volatile LAS unsigned* bst = (volatile LAS unsigned*)(L + LDS_BYTES - 16);
    if (raw_tid() == 0) { bst[0] = 0u; bst[1] = 0u; }
    __syncthreads();
    const XcdBarrier xbar = xcd_barrier_post((unsigned*)(ws + WS_BAR), bst);
#define WSO(T, off) ((T*)(ws_op(ws) + (off)))
#define Win0   WSO(bf16_t, WS_WIN0)
#define Wout0  WSO(bf16_t, WS_WOUT0)
#define Wrin   WSO(bf16_t, WS_WRIN)
#define Wrout  WSO(bf16_t, WS_WROUT)
#define Wup    WSO(bf16_t, WS_WUP)
#define Wdn    WSO(bf16_t, WS_WDN)
#define rope64  WSO(float2, WS_ROPE64)
#define rope256 WSO(float2, WS_ROPE256)
#define SS     WSO(float, WS_SS)
#define H      WSO(bf16_t, WS_H)
#define P      WSO(bf16_t, WS_P)
#define O      WSO(bf16_t, WS_O)
#define R      WSO(bf16_t, WS_R)
    int boff = 0;
    prep_matrix(L, p.even_w_in, D, EIN, p.attn_norm, Win0, 0, 512, 1536, 2048, 0.125f * LOG2E, boff, false, 1536, 2560, 64);
    prep_matrix(L, p.even_w_out, D, D, nullptr, Wout0, 0, 0, 0, 0, 1.f, boff);
    prep_matrix(L, p.ret_w_in, D, RIN, p.attn_norm + D, Wrin, 0, 1024, 0, 0, 0.0625f, boff, false, 0, 2048, 256);
    prep_matrix(L, p.ret_w_out, RMIX, D, nullptr, Wrout, 0, 0, 0, 0, 1.f, boff);
    prep_matrix(L, p.ffn_w_up, D, F2, p.ffn_norm, Wup, 0, 0, 0, 0, 1.f, boff, true);
    prep_matrix(L, p.ffn_w_up + (size_t)D * F2, D, F2, p.ffn_norm + D, Wup + (size_t)F2 * D, 0, 0, 0, 0, 1.f, boff, true);
    prep_matrix(L, p.ffn_w_down, FF, D, nullptr, Wdn, 0, 0, 0, 0, 1.f, boff);
    prep_matrix(L, p.ffn_w_down + (size_t)FF * D, FF, D, nullptr, Wdn + (size_t)D * FF, 0, 0, 0, 0, 1.f, boff);
    rope_tables(rope64, rope256);
    if (blockIdx.x == 0 && raw_tid() < 8) WSO(float, WS_LG2)[raw_tid()] = -softplus_f((raw_tid() < 4 ? p.dec_f : p.dec_b)[raw_tid() & 3]) * LOG2E;
    grid.sync();

#pragma unroll 1
    for (int g = 0; g < NGRP; ++g) {
        const int nseq = g < 2 ? GSEQ : 4, T = nseq * SEQ;
        const float* xin = g < 2 ? p.xp + (size_t)g * TG * D : p.xs;
        float* xo = p.out + (size_t)g * TG * D;
        cvt_phase(xin, H, SS, T); xcd_barrier(xbar);
        run_gemm(L, H, Win0, T, EIN, D, EpiBf16{P, EIN, SS, L, rope64, 6, 10, 64}); xcd_barrier(xbar);
        attn_phase(L, P, O, p.na_rpb, nseq); xcd_barrier(xbar);
        run_gemm(L, O, Wout0, T, D, D, EpiRes<false>{H, nullptr, SS + 16 * (size_t)TG, H}); xcd_barrier(xbar);
        run_gemm(L, H, Wup, T, F2, D, EpiConv{O, SS + 16 * (size_t)TG, L, p.conv_w, p.conv_b, WSO(bf16_t, WS_EDGE)}); xcd_barrier(xbar);
        ffn_fix_phase(WSO(bf16_t, WS_EDGE), O, p.conv_w, p.conv_b, T); xcd_barrier(xbar);
        run_gemm(L, O, Wdn, T, D, FF, EpiRes<false>{H, nullptr, SS + 32 * (size_t)TG, H}); xcd_barrier(xbar);
        run_gemm(L, H, Wrin, T, RIN, D, EpiBf16{P, RIN, SS + 32 * (size_t)TG, L, rope256, 0, 8, 256}); xcd_barrier(xbar);
        ret_phase(L, P, R, WSO(float, WS_LG2), nseq); xcd_barrier(xbar);
        ret_combine_phase(R, P, O, T); xcd_barrier(xbar);
        run_gemm(L, O, Wrout, T, D, RMIX, EpiRes<false>{H, nullptr, SS + 48 * (size_t)TG, H}); xcd_barrier(xbar);
        run_gemm(L, H, Wup + (size_t)F2 * D, T, F2, D, EpiConv{O, SS + 48 * (size_t)TG, L, p.conv_w + 3 * F2, p.conv_b + F2, WSO(bf16_t, WS_EDGE)}); xcd_barrier(xbar);
        ffn_fix_phase(WSO(bf16_t, WS_EDGE), O, p.conv_w + 3 * F2, p.conv_b + F2, T); xcd_barrier(xbar);
        run_gemm(L, O, Wdn + (size_t)D * FF, T, D, FF, EpiRes<false>{H, nullptr, SS + 16 * (size_t)TG, R}); xcd_barrier(xbar);
        final_norm_phase(R, SS + 16 * (size_t)TG, xo, p.final_norm, T);
    }
}

#undef Win0
#undef Wout0
#undef Wrin
#undef Wrout
#undef Wup
#undef Wdn
#undef rope64
#undef rope256
#undef SS
#undef H
#undef P
#undef O
#undef R
#undef WSO

extern "C" void kernel_launch(void* const* d_in, const int* in_sizes, int n_in, void* d_out, int out_size, void* d_ws, size_t ws_size, hipStream_t stream) {
    static int grid_blocks = 0;
    if (grid_blocks == 0) {
        int dev = 0, cus = 0, per_cu = 0;
        (void)hipGetDevice(&dev);
        (void)hipDeviceGetAttribute(&cus, hipDeviceAttributeMultiprocessorCount, dev);
        if (hipFuncSetAttribute((const void*)mega_fwd, hipFuncAttributeMaxDynamicSharedMemorySize, LDS_BYTES) != hipSuccess) fprintf(stderr, "kernel_launch: hipFuncSetAttribute failed\n");
        if (hipOccupancyMaxActiveBlocksPerMultiprocessor(&per_cu, (const void*)mega_fwd, NTHR, LDS_BYTES) != hipSuccess || per_cu < 1) { fprintf(stderr, "kernel_launch: occupancy query says %d\n", per_cu); per_cu = 1; }
        (void)hipGetLastError();
        grid_blocks = cus * 1;
        if (ws_size < WS_END) fprintf(stderr, "kernel_launch: workspace too small: %zu < %zu\n", ws_size, (size_t)WS_END);
    }
    Params p{};
    p.xp = (const float*)d_in[0]; p.xs = (const float*)d_in[1]; p.attn_norm = (const float*)d_in[2]; p.even_w_in = (const float*)d_in[3]; p.na_rpb = (const float*)d_in[4];
    p.even_w_out = (const float*)d_in[5]; p.ret_w_in = (const float*)d_in[6]; p.dec_f = (const float*)d_in[7]; p.dec_b = (const float*)d_in[8]; p.ret_w_out = (const float*)d_in[9];
    p.ffn_norm = (const float*)d_in[10]; p.ffn_w_up = (const float*)d_in[11]; p.conv_w = (const float*)d_in[12]; p.conv_b = (const float*)d_in[13]; p.ffn_w_down = (const float*)d_in[14];
    p.final_norm = (const float*)d_in[15];
    p.out = (float*)d_out; p.ws = (unsigned char*)d_ws;
    (void)hipMemsetAsync((unsigned char*)d_ws + WS_BAR, 0, 16384, stream);
    void* args[] = {&p};
    hipError_t e = hipLaunchCooperativeKernel((const void*)mega_fwd, dim3(grid_blocks), dim3(NTHR), args, LDS_BYTES, stream);
    if (e != hipSuccess) fprintf(stderr, "kernel_launch: cooperative launch failed: %s (grid %d)\n", hipGetErrorString(e), grid_blocks);
}
```
